# Optimizing an MI355X kernel written in HIP

```python
import jax, jax.numpy as jnp
from jax import lax
import numpy as np

D_MODEL = 1024
BATCH = 32
SEQ = 256
DEPTH = 2
DEC_BATCH = 8
DEC_SEQ = 2048
PAST_LEN = 256

GRID_W = 64
MIX_W = D_MODEL
DN_HEADS = 4
DK = 128
DV = 128
DN_W = DN_HEADS * DV
POOL_GROUPS = 4
POOL_W = MIX_W - DN_W
POOL_GC = POOL_W // POOL_GROUPS
POOL_WINDOWS = (2, 4, 8, 16)
CONV_K = 5
CHUNK = 64
D_FF = -(-(8 * D_MODEL) // (3 * 256)) * 256
IN_COLS = 3 * DN_W + DN_W + 4 * DN_HEADS + POOL_W
EPS = 1e-6

kernel_name = "hymba_gdn_pool_diffusion_step"


def rmsnorm(x, gain):
    xf = x.astype(jnp.float32)
    y = xf * lax.rsqrt(jnp.mean(xf * xf, axis=-1, keepdims=True) + EPS)
    return (y * gain.astype(jnp.float32)).astype(x.dtype)


def l2norm(x):
    xf = x.astype(jnp.float32)
    return xf * lax.rsqrt(jnp.sum(xf * xf, axis=-1, keepdims=True) + EPS)


def centred_conv(x, w):
    pad = CONV_K // 2
    n = x.shape[1]
    xp = jnp.pad(x, ((0, 0), (pad, pad), (0, 0)))
    out = xp[:, 0:n] * w[0]
    for j in range(1, CONV_K):
        out = out + xp[:, j:j + n] * w[j]
    return out


def box_mean(x, window, axis):
    n = x.shape[axis]
    cs = jnp.cumsum(x.astype(jnp.float32), axis=axis)
    pad_cfg = [(0, 0)] * x.ndim
    pad_cfg[axis] = (1, 0)
    cs = jnp.pad(cs, pad_cfg)
    t = jnp.arange(n)
    lo = jnp.clip(t - window // 2, 0, n)
    hi = jnp.clip(t - window // 2 + window, 0, n)
    s = jnp.take(cs, hi, axis=axis) - jnp.take(cs, lo, axis=axis)
    cnt_shape = [1] * x.ndim
    cnt_shape[axis] = n
    cnt = (hi - lo).astype(jnp.float32).reshape(cnt_shape)
    return (s / cnt).astype(x.dtype)


def pool_mix(u, pool_w, pool_scale, rows):
    b, n, _ = u.shape
    outs = []
    for gi, win in enumerate(POOL_WINDOWS):
        ug = u[..., gi * POOL_GC:(gi + 1) * POOL_GC]
        if rows is None:
            m = box_mean(ug, win, 1)
        else:
            grid = ug.reshape(b, rows, GRID_W, POOL_GC)
            m = box_mean(box_mean(grid, win, 1), win, 2).reshape(b, n, POOL_GC)
        outs.append((m - ug) @ pool_w[gi])
    return jnp.concatenate(outs, axis=-1) * pool_scale


def gated_delta_chunked(q, k, v, g, beta, s0):
    b, n, h, _ = q.shape
    nc = n // CHUNK
    f32 = jnp.float32

    def chunks(x):
        return x.astype(f32).reshape(b, nc, CHUNK, h, -1).transpose(0, 3, 1, 2, 4)

    q, k, v = chunks(q), chunks(k), chunks(v)
    beta = chunks(beta[..., None])[..., 0]
    gc = jnp.cumsum(chunks(g[..., None])[..., 0], axis=-1)
    idx = jnp.arange(CHUNK)
    causal = idx[:, None] >= idx[None, :]
    strict = idx[:, None] > idx[None, :]
    diff = gc[..., :, None] - gc[..., None, :]
    decay = jnp.where(causal, jnp.exp(jnp.where(causal, diff, 0.0)), 0.0)
    k_beta = k * beta[..., None]
    lower = jnp.where(strict, jnp.einsum('bhnik,bhnjk->bhnij', k_beta, k) * decay, 0.0)
    a_mat = lower + jnp.eye(CHUNK, dtype=f32)
    u = lax.linalg.triangular_solve(a_mat, v * beta[..., None], left_side=True, lower=True)
    w = lax.linalg.triangular_solve(a_mat, k_beta * jnp.exp(gc)[..., None], left_side=True, lower=True)
    attn = jnp.einsum('bhnik,bhnjk->bhnij', q, k) * decay
    xs = tuple(jnp.moveaxis(t, 2, 0) for t in (q, k, u, w, attn, gc))

    def step(s, inp):
        qi, ki, ui, wi, ai, gi = inp
        v_new = ui - jnp.einsum('bhck,bhkv->bhcv', wi, s)
        o = jnp.einsum('bhck,bhkv->bhcv', qi * jnp.exp(gi)[..., None], s) + jnp.einsum('bhij,bhjv->bhiv', ai, v_new)
        g_last = gi[..., -1]
        s = s * jnp.exp(g_last)[..., None, None] + jnp.einsum(
            'bhck,bhcv->bhkv', ki * jnp.exp(g_last[..., None] - gi)[..., None], v_new)
        return s, o

    s_final, o = lax.scan(step, s0.astype(f32), xs)
    o = jnp.moveaxis(o, 0, 2)
    o = o.transpose(0, 2, 3, 1, 4).reshape(b, n, h, DV)
    return o, s_final


def mixer(h, w_in, conv_w, a_log, dt_bias, dn_norm, pool_w, pool_scale, w_out, s0_f, s0_b, rows):
    b, n, _ = h.shape
    proj = h @ w_in
    qkv = jax.nn.silu(centred_conv(proj[..., :3 * DN_W], conv_w))
    z = proj[..., 3 * DN_W:4 * DN_W]
    ab = proj[..., 4 * DN_W:4 * DN_W + 4 * DN_HEADS].astype(jnp.float32).reshape(b, n, 4, DN_HEADS)
    u_pool = proj[..., 4 * DN_W + 4 * DN_HEADS:]
    q = l2norm(qkv[..., :DN_W].reshape(b, n, DN_HEADS, DK)) * (DK ** -0.5)
    k = l2norm(qkv[..., DN_W:2 * DN_W].reshape(b, n, DN_HEADS, DK))
    v = qkv[..., 2 * DN_W:].reshape(b, n, DN_HEADS, DV)
    beta = jax.nn.sigmoid(ab[:, :, 0:2])
    g = -jnp.exp(a_log.astype(jnp.float32)) * jax.nn.softplus(ab[:, :, 2:4] + dt_bias.astype(jnp.float32))
    o_f, s_f = gated_delta_chunked(q, k, v, g[:, :, 0], beta[:, :, 0], s0_f)
    o_b, s_b = gated_delta_chunked(jnp.flip(q, 1), jnp.flip(k, 1), jnp.flip(v, 1),
                                   jnp.flip(g[:, :, 1], 1), jnp.flip(beta[:, :, 1], 1), s0_b)
    o = o_f + jnp.flip(o_b, 1)
    o = rmsnorm(o, dn_norm) * jax.nn.silu(z.reshape(b, n, DN_HEADS, DV).astype(jnp.float32))
    o = o.reshape(b, n, DN_W).astype(h.dtype)
    p = pool_mix(u_pool, pool_w, pool_scale, rows).astype(h.dtype)
    out = jnp.concatenate([o, p], axis=-1) @ w_out
    return out, s_f, s_b


def layer(x, ada, norm_mix, norm_ffn, w_in, conv_w, a_log, dt_bias, dn_norm, pool_w, pool_scale,
          w_out, w_gu, w_down, s0_f, s0_b, rows):
    sh_m, sc_m, g_m, sh_f, sc_f, g_f = jnp.split(ada, 6, axis=-1)
    h = (rmsnorm(x, norm_mix) * (1 + sc_m) + sh_m).astype(x.dtype)
    mix, s_f, s_b = mixer(h, w_in, conv_w, a_log, dt_bias, dn_norm, pool_w, pool_scale, w_out, s0_f, s0_b, rows)
    x = (x + g_m * mix).astype(x.dtype)
    h = (rmsnorm(x, norm_ffn) * (1 + sc_f) + sh_f).astype(x.dtype)
    gu = h @ w_gu
    x = (x + g_f * ((jax.nn.silu(gu[..., :D_FF]) * gu[..., D_FF:]) @ w_down)).astype(x.dtype)
    return x, s_f, s_b


def setup_inputs(seed: int = 0) -> dict:
    key = jax.random.key(seed)
    ks = jax.random.split(key, 20)
    nrm = jax.random.normal
    f32 = jnp.float32
    return {
        "x_prompt": nrm(ks[0], (BATCH, SEQ, D_MODEL), f32),
        "x_sample": nrm(ks[1], (DEC_BATCH, DEC_SEQ, D_MODEL), f32),
        "c": nrm(ks[2], (DEC_BATCH, D_MODEL), f32),
        "state_delta": 0.5 * nrm(ks[3], (DEC_BATCH, DEPTH, 2, DN_HEADS, DK, DV), f32),
        "c_ctx": nrm(ks[4], (D_MODEL,), f32),
        "w_ada": 0.5 * D_MODEL ** -0.5 * nrm(ks[5], (DEPTH, D_MODEL, 6 * D_MODEL), f32),
        "b_ada": 0.02 * nrm(ks[6], (DEPTH, 6 * D_MODEL), f32),
        "norm_mix": 1.0 + 0.05 * nrm(ks[7], (DEPTH, D_MODEL), f32),
        "norm_ffn": 1.0 + 0.05 * nrm(ks[8], (DEPTH, D_MODEL), f32),
        "w_in": D_MODEL ** -0.5 * nrm(ks[9], (DEPTH, D_MODEL, IN_COLS), f32),
        "conv_w": CONV_K ** -0.5 * nrm(ks[10], (DEPTH, CONV_K, 3 * DN_W), f32),
        "a_log": jnp.log(jax.random.uniform(ks[11], (DEPTH, 2, DN_HEADS), f32, 1.0, 16.0)),
        "dt_bias": jnp.log(jnp.expm1(jax.random.uniform(ks[12], (DEPTH, 2, DN_HEADS), f32, 0.001, 0.1))),
        "dn_norm": 1.0 + 0.05 * nrm(ks[13], (DEPTH, DV), f32),
        "pool_w": POOL_GC ** -0.5 * nrm(ks[14], (DEPTH, POOL_GROUPS, POOL_GC, POOL_GC), f32),
        "pool_scale": 1.0 + 0.1 * nrm(ks[15], (DEPTH, POOL_W), f32),
        "w_out": MIX_W ** -0.5 * nrm(ks[16], (DEPTH, MIX_W, D_MODEL), f32),
        "w_gu": D_MODEL ** -0.5 * nrm(ks[17], (DEPTH, D_MODEL, 2 * D_FF), f32),
        "w_down": D_FF ** -0.5 * nrm(ks[18], (DEPTH, D_FF, D_MODEL), f32),
        "final_norm": 1.0 + 0.05 * nrm(ks[19], (D_MODEL,), f32),
    }


def reference(x_prompt, x_sample, c, state_delta, c_ctx, w_ada, b_ada, norm_mix, norm_ffn, w_in, conv_w,
              a_log, dt_bias, dn_norm, pool_w, pool_scale, w_out, w_gu, w_down, final_norm):
    xp = x_prompt
    bp = x_prompt.shape[0]
    zero_state = jnp.zeros((bp, DN_HEADS, DK, DV), jnp.float32)
    ctx_states = []
    for l in range(DEPTH):
        ada = (jax.nn.silu(c_ctx) @ w_ada[l] + b_ada[l])[None, None, :]
        xp, s_f, s_b = layer(xp, ada, norm_mix[l], norm_ffn[l], w_in[l], conv_w[l], a_log[l], dt_bias[l],
                             dn_norm[l], pool_w[l], pool_scale[l], w_out[l], w_gu[l], w_down[l],
                             zero_state, zero_state, None)
        ctx_states.append(jnp.stack([s_f, s_b], axis=1))
    new_state_delta = jnp.stack(ctx_states, axis=1)
    y_prompt = rmsnorm(xp, final_norm)

    xs = x_sample
    rows = x_sample.shape[1] // GRID_W
    for l in range(DEPTH):
        ada = (jax.nn.silu(c) @ w_ada[l] + b_ada[l])[:, None, :]
        xs, _, _ = layer(xs, ada, norm_mix[l], norm_ffn[l], w_in[l], conv_w[l], a_log[l], dt_bias[l],
                         dn_norm[l], pool_w[l], pool_scale[l], w_out[l], w_gu[l], w_down[l],
                         state_delta[:, l, 0], state_delta[:, l, 1], rows)
    y_sample = rmsnorm(xs, final_norm)
    return (y_prompt, y_sample, new_state_delta)
```

```cpp
#include <hip/hip_runtime.h>
#include <hip/hip_cooperative_groups.h>
#include <cstdio>
namespace cg = cooperative_groups;

typedef __attribute__((ext_vector_type(8))) short bf16x8;
typedef __attribute__((ext_vector_type(4))) short s16x4;
typedef __attribute__((ext_vector_type(16))) float f32x16;
typedef __attribute__((ext_vector_type(2))) __bf16 bf2_t;
typedef __attribute__((ext_vector_type(2))) float f2_t;
typedef unsigned short u16;

#define DI __device__ __forceinline__
#define MFMA(a, b, c) __builtin_amdgcn_mfma_f32_32x32x16_bf16((a), (b), (c), 0, 0, 0)

DI unsigned pack2(float a, float b) { f2_t v = {a, b}; return __builtin_bit_cast(unsigned, __builtin_convertvector(v, bf2_t)); }
DI u16 f2bf(float a) { return (u16)(pack2(a, 0.f) & 0xffffu); }
DI float bf2f(u16 x) { return __uint_as_float(((unsigned)x) << 16); }
DI float bflo(unsigned x) { return __uint_as_float(x << 16); }
DI float bfhi(unsigned x) { return __uint_as_float(x & 0xffff0000u); }
DI int crow(int reg, int h) { return (reg & 3) + 8 * (reg >> 2) + 4 * h; }
typedef float nt_f4 __attribute__((ext_vector_type(4)));
typedef unsigned nt_u2 __attribute__((ext_vector_type(2)));
DI float4 nt_load4f(const float* q) { nt_f4 v = __builtin_nontemporal_load((const nt_f4*)q); return make_float4(v[0], v[1], v[2], v[3]); }
DI void nt_store4f(float* q, float4 v) { nt_f4 w = {v.x, v.y, v.z, v.w}; __builtin_nontemporal_store(w, (nt_f4*)q); }
typedef unsigned nt_u4 __attribute__((ext_vector_type(4)));
DI uint4 nt_load4u(const u16* q) { nt_u4 v = __builtin_nontemporal_load((const nt_u4*)q); return make_uint4(v[0], v[1], v[2], v[3]); }
DI uint2 nt_load2u(const u16* q) { nt_u2 v = __builtin_nontemporal_load((const nt_u2*)q); return make_uint2(v[0], v[1]); }
DI float siluf(float x) { return x * __builtin_amdgcn_rcpf(1.f + __expf(-x)); }

constexpr int NT = 24576;
constexpr int NCTX = 8192;
constexpr int DM = 1024;
constexpr int DFF = 2816;
constexpr int INC = 2576;
constexpr int INP = 2816;
constexpr float EPSF = 1e-6f;
DI int raw_tid_f(const int wid_s) {
  unsigned m = ~0u;
  asm volatile("" : "+s"(m));
  int t = wid_s * 64 + (int)__builtin_amdgcn_mbcnt_hi(m, __builtin_amdgcn_mbcnt_lo(m, 0u));
  asm volatile("" : "+v"(t));
  return t;
}
#define RAWTID raw_tid_f(wid_s)
#define raw_tid() RAWTID
#define VB ((int)(blockIdx.x * 2 + (raw_tid() >> 8)))
#define VGRID ((int)(gridDim.x * 2))
#define VTID ((int)(raw_tid() & 255))

constexpr size_t OFF_R0 = 0;
constexpr size_t OFF_R1 = 75497472;
constexpr size_t OFF_R2 = 150994944;
constexpr size_t OFF_R3 = 176160768;
constexpr size_t OFF_R4 = 201326592;
constexpr size_t OFF_WIN = 256114688;
constexpr size_t OFF_WOUT = 231997440;
constexpr size_t OFF_WGU = 234094592;
constexpr size_t OFF_WDN = 245628928;
constexpr size_t OFF_GB = 251396096;
constexpr size_t OFF_ADAP = 255533568;
constexpr size_t OFF_GC = 254738432;
constexpr size_t OFF_T = OFF_R0;
constexpr size_t OFF_ATT = OFF_R0 + 25165824;
constexpr size_t OFF_OB = OFF_R0 + 50331648;
constexpr int ADAP_STRIDE = 2 * 9 * 6144;
constexpr size_t OFF_GATE = 255533568;


struct Params {
  const float *x_prompt, *x_sample, *c, *state_delta, *c_ctx, *w_ada, *b_ada, *norm_mix, *norm_ffn, *w_in, *conv_w,
      *a_log, *dt_bias, *dn_norm, *pool_w, *pool_scale, *w_out, *w_gu, *w_down, *final_norm;
  float* out;
  char* ws;
};

DI float ada_get(const float* adap, int l, int ci, int j) {
  return adap[((size_t)l * 9 + ci) * 6144 + j];
}
DI int cond_idx(int t) { return t < NCTX ? 0 : 1 + ((t - NCTX) >> 11); }
DI const float* xrow(const Params& p, bool from_input, int t) {
  if (from_input) return t < NCTX ? p.x_prompt + (size_t)t * DM : p.x_sample + (size_t)(t - NCTX) * DM;
  return p.out + (size_t)t * DM;
}

DI void phase_ada(const Params& p, const int wid_s, char* smem) {
  float* s_silu = (float*)smem;
  float* s_red = s_silu + 9 * 256;
  float* adap = (float*)(p.ws + OFF_ADAP);
  int tid_ = VTID; asm volatile("" : "+v"(tid_)); const int tid = tid_, lane = tid & 63, wv = tid >> 6;
  for (int it = VB; it < 768; it += VGRID) {
    const int kq = it & 3, ct = (it >> 2) % 96, l = it / 384;
    __syncthreads();
    for (int e = tid; e < 9 * 256; e += 256) {
      int ci = e >> 8, k = kq * 256 + (e & 255);
      float cv = (ci == 0) ? p.c_ctx[k] : p.c[(ci - 1) * 1024 + k];
      s_silu[e] = siluf(cv);
    }
    __syncthreads();
    float acc[9];
#pragma unroll
    for (int ci = 0; ci < 9; ++ci) acc[ci] = 0.f;
    const float* w = p.w_ada + ((size_t)l * 1024 + kq * 256 + wv * 64) * 6144 + ct * 64 + lane;
#pragma unroll 8
    for (int k = 0; k < 64; ++k) {
      float wvv = __builtin_nontemporal_load(&w[(size_t)k * 6144]);
#pragma unroll
      for (int ci = 0; ci < 9; ++ci) acc[ci] += s_silu[ci * 256 + wv * 64 + k] * wvv;
    }
#pragma unroll
    for (int ci = 0; ci < 9; ++ci) s_red[(wv * 9 + ci) * 64 + lane] = acc[ci];
    __syncthreads();
    for (int e = tid; e < 9 * 64; e += 256) {
      int ci = e >> 6, cl = e & 63;
      float v = s_red[(0 * 9 + ci) * 64 + cl] + s_red[(1 * 9 + ci) * 64 + cl] + s_red[(2 * 9 + ci) * 64 + cl] +
                s_red[(3 * 9 + ci) * 64 + cl];
      int col = ct * 64 + cl;
      if (kq == 0) v += p.b_ada[l * 6144 + col];
      atomicAdd(&adap[((size_t)l * 9 + ci) * 6144 + col], v);
    }
  }
}

DI void phase_wconv(const Params& p, const int wid_s, int l, char* smem, int lo, int hi, bool do_fold, int hb, int nhb) {
  float* tile = (float*)smem;
  int tid_ = VTID; asm volatile("" : "+v"(tid_)); const int tid = tid_;
  for (int it0 = lo + hb; it0 < hi; it0 += nhb) {
    int it = it0;
    const float* src; int ld, ldd, n0, k0, mode; u16* dst;
    if (it < 704) { mode = 0; n0 = (it / 16) * 64; k0 = (it % 16) * 64; src = p.w_in + (size_t)l * 1024 * INC; ld = INC; dst = (u16*)(p.ws + OFF_WIN); ldd = 1024; }
    else if (it < 2112) { it -= 704; mode = 1; n0 = (it / 16) * 64; k0 = (it % 16) * 64; src = p.w_gu + (size_t)l * 1024 * 5632; ld = 5632; dst = (u16*)(p.ws + OFF_WGU); ldd = 1024; }
    else if (it < 2816) { it -= 2112; mode = 2; n0 = (it / 44) * 64; k0 = (it % 44) * 64; src = p.w_down + (size_t)l * DFF * 1024; ld = 1024; dst = (u16*)(p.ws + OFF_WDN); ldd = DFF; }
    else { it -= 2816; mode = 3; n0 = (it / 16) * 64; k0 = (it % 16) * 64; src = p.w_out + (size_t)l * 1024 * 1024; ld = 1024; dst = (u16*)(p.ws + OFF_WOUT); ldd = 1024; }
    if (mode == 3 && k0 >= 512) continue;
    __syncthreads();
    {
      const int n4 = tid & 15;
      const int np = n0 + n4 * 4;
      int col = np; bool valid = true;
      if (mode == 0) {
        if (np < 2048) col = np; else if (np < 2560) col = np + 16; else if (np < 2576) col = np - 512; else { valid = false; col = 0; }
      } else if (mode == 1) {
        int tl = np >> 8, bj = (np >> 7) & 1, wc = (np >> 5) & 3, half = (np >> 4) & 1, j = np & 15;
        col = half * DFF + tl * 128 + bj * 64 + wc * 16 + j;
      }
#pragma unroll
      for (int i = 0; i < 4; ++i) {
        const int kk = (tid >> 4) + 16 * i;
        float4 v = {0.f, 0.f, 0.f, 0.f};
        if (valid) v = nt_load4f(src + (size_t)(k0 + kk) * ld + col);
        *(float4*)(tile + kk * 68 + n4 * 4) = v;
      }
    }
    __syncthreads();
    {
      const int n = tid & 63;
#pragma unroll
      for (int i = 0; i < 2; ++i) {
        const int k8 = (tid >> 6) + 4 * i;
        float e[8];
#pragma unroll
        for (int q = 0; q < 8; ++q) e[q] = tile[(k8 * 8 + q) * 68 + n];
        uint4 o;
        o.x = pack2(e[0], e[1]); o.y = pack2(e[2], e[3]); o.z = pack2(e[4], e[5]); o.w = pack2(e[6], e[7]);
        *(uint4*)(dst + (size_t)(n0 + n) * ldd + k0 + k8 * 8) = o;
      }
    }
  }
  if (do_fold) {
    u16* dst = (u16*)(p.ws + OFF_WOUT);
    const float* wo = p.w_out + (size_t)l * 1024 * 1024;
    float* pwl = (float*)smem;
    float* psl = pwl + 16 * 128;
    for (int it = hb; it < 128; it += nhb) {
      const int ntile = it & 3, ib = (it >> 2) & 7, g = it >> 5;
      const int n = ntile * 256 + tid;
      const float* pw = p.pool_w + (((size_t)l * 4 + g) * 128 + ib * 16) * 128;
      const float* ps = p.pool_scale + l * 512 + g * 128;
      __syncthreads();
#pragma unroll
      for (int i = 0; i < 8; ++i) pwl[tid + 256 * i] = pw[tid + 256 * i];
      if (tid < 128) psl[tid] = ps[tid];
      __syncthreads();
      const float* wsrc = wo + (size_t)(512 + 128 * g) * 1024 + n;
      float acc[16];
#pragma unroll
      for (int i = 0; i < 16; ++i) acc[i] = 0.f;
#pragma unroll 2
      for (int j = 0; j < 128; j += 4) {
        const float4 s4 = *(const float4*)(psl + j);
        const float w0 = wsrc[(size_t)(j + 0) * 1024] * s4.x, w1 = wsrc[(size_t)(j + 1) * 1024] * s4.y;
        const float w2 = wsrc[(size_t)(j + 2) * 1024] * s4.z, w3 = wsrc[(size_t)(j + 3) * 1024] * s4.w;
#pragma unroll
        for (int i = 0; i < 16; ++i) {
          const float4 c = *(const float4*)(pwl + i * 128 + j);
          acc[i] += c.x * w0 + c.y * w1 + c.z * w2 + c.w * w3;
        }
      }
      uint4 o0, o1;
      o0.x = pack2(acc[0], acc[1]); o0.y = pack2(acc[2], acc[3]); o0.z = pack2(acc[4], acc[5]); o0.w = pack2(acc[6], acc[7]);
      o1.x = pack2(acc[8], acc[9]); o1.y = pack2(acc[10], acc[11]); o1.z = pack2(acc[12], acc[13]); o1.w = pack2(acc[14], acc[15]);
      u16* op = dst + (size_t)n * 1024 + 512 + 128 * g + ib * 16;
      *(uint4*)(op) = o0;
      *(uint4*)(op + 8) = o1;
    }
  }
}

DI void phase_modnorm(const Params& p, const int wid_s, int l, int which, bool from_input, u16* hbuf, const u16* delta, int gl, int gchunk) {
  const float* adap = (const float*)(p.ws + OFF_ADAP);
  const float* gain = (which ? p.norm_ffn : p.norm_mix) + l * 1024;
  int tid_ = VTID; asm volatile("" : "+v"(tid_)); const int tid = tid_, lane = tid & 63, wv = tid >> 6;
  for (int it = VB; it < 1536; it += VGRID) {
    const int tb = it * 16, ci = cond_idx(tb);
    float sc[16], sh[16], gt[16];
#pragma unroll
    for (int q = 0; q < 4; ++q)
#pragma unroll
      for (int e = 0; e < 4; ++e) {
        int c = q * 256 + lane * 4 + e;
        sc[q * 4 + e] = gain[c] * (1.f + ada_get(adap, l, ci, (which ? 4 : 1) * 1024 + c));
        sh[q * 4 + e] = ada_get(adap, l, ci, (which ? 3 : 0) * 1024 + c);
        gt[q * 4 + e] = delta ? ada_get(adap, gl, ci, gchunk * 1024 + c) : 0.f;
      }
    float4 v[4][4];
    uint2 dl[4][4];
#pragma unroll
    for (int rr = 0; rr < 4; ++rr) {
      const int t = tb + wv * 4 + rr;
      const float* xr = xrow(p, from_input, t);
#pragma unroll
      for (int q = 0; q < 4; ++q) {
        v[rr][q] = nt_load4f(xr + q * 256 + lane * 4);
        if (delta) dl[rr][q] = nt_load2u(delta + (size_t)t * 1024 + q * 256 + lane * 4);
      }
    }
#pragma unroll
    for (int rr = 0; rr < 4; ++rr) {
      const int t = tb + wv * 4 + rr;
      float ss = 0.f;
#pragma unroll
      for (int q = 0; q < 4; ++q) {
        if (delta) {
          const uint2 d2 = dl[rr][q];
          v[rr][q].x += gt[q * 4 + 0] * bflo(d2.x); v[rr][q].y += gt[q * 4 + 1] * bfhi(d2.x);
          v[rr][q].z += gt[q * 4 + 2] * bflo(d2.y); v[rr][q].w += gt[q * 4 + 3] * bfhi(d2.y);
          nt_store4f(p.out + (size_t)t * DM + q * 256 + lane * 4, v[rr][q]);
        }
        ss += v[rr][q].x * v[rr][q].x + v[rr][q].y * v[rr][q].y + v[rr][q].z * v[rr][q].z + v[rr][q].w * v[rr][q].w;
      }
#pragma unroll
      for (int o = 32; o > 0; o >>= 1) ss += __shfl_xor(ss, o);
      const float rstd = rsqrtf(ss * (1.f / 1024.f) + EPSF);
#pragma unroll
      for (int q = 0; q < 4; ++q) {
        uint2 o2;
        o2.x = pack2(v[rr][q].x * rstd * sc[q * 4 + 0] + sh[q * 4 + 0], v[rr][q].y * rstd * sc[q * 4 + 1] + sh[q * 4 + 1]);
        o2.y = pack2(v[rr][q].z * rstd * sc[q * 4 + 2] + sh[q * 4 + 2], v[rr][q].w * rstd * sc[q * 4 + 3] + sh[q * 4 + 3]);
        *(uint2*)(hbuf + (size_t)t * 1024 + q * 256 + lane * 4) = o2;
      }
    }
  }
}

enum { EPI_PROJ = 0, EPI_RESID = 1, EPI_SWIGLU = 2 };
typedef __attribute__((ext_vector_type(4))) float f32x4;

DI int lds_byte(int r, int c) {
  int st = (r >> 4) * 2 + (c >> 5), rr = r & 15, cc = c & 31, ob = rr * 64 + cc * 2;
  return st * 1024 + (ob ^ (((ob >> 9) & 1) << 5));
}
DI void stage_rc(int b, int& R, int& C) {
  int st = b / 1024, sb = b % 1024, swz = sb ^ (((sb >> 9) & 1) << 5);
  R = (st >> 1) * 16 + swz / 64;
  C = (st & 1) * 32 + (swz % 64) / 2;
}

template <int EPI>
DI void gemm8p(const Params& p, const int wid_s, int l, const u16* A0, const u16* A1, int ksplit, int lda, const u16* Bt, int ldb,
              int K, int nN, int gate_chunk, bool x_from_input, char* smem) {
  constexpr int BM = 256, BK = 64, HALF = 128, HT = HALF * BK, NXCD = 8, WGM = 8;
  u16* shm = (u16*)smem;
#define SA(b, h) (shm + ((b) * 2 + (h)) * HT)
#define SB(b, h) (shm + (4 + (b) * 2 + (h)) * HT)
#define STAGE_(P, BASE, LD, OFF, br, kcol)                                                            \
  do {                                                                                                \
    _Pragma("unroll") for (int _i = 0; _i < 2; ++_i) {                                                \
      __builtin_amdgcn_global_load_lds((const unsigned*)((BASE) + ((size_t)((br) + 64 * _i) * (LD) + (kcol)) + (OFF)), \
                                       (__attribute__((address_space(3))) unsigned*)((char*)(P) + lds_dst + _i * 8192), 16, 0, 0); \
    }                                                                                                 \
  } while (0)
#define STAGE_A(P, br, kt) do { const int _k0 = (kt) * BK; const bool _lo = _k0 < ksplit; const u16* _ab = _lo ? A0 : A1; const int _kc = _lo ? _k0 : _k0 - ksplit; STAGE_(P, _ab, lda, offA, br, _kc); } while (0)
#define STAGE_B(P, br, kt) STAGE_(P, Bt, ldb, offB, br, (kt) * BK)
#define LDA(dst, b, h) _Pragma("unroll") for (int m = 0; m < 4; ++m) _Pragma("unroll") for (int k = 0; k < 2; ++k) \
    dst[m][k] = *reinterpret_cast<const bf16x8*>((char*)SA(b, h) + a_lane + (m * 2 + k) * 1024)
#define LDB(dst, b, h) _Pragma("unroll") for (int n = 0; n < 2; ++n) _Pragma("unroll") for (int k = 0; k < 2; ++k) \
    dst[n][k] = *reinterpret_cast<const bf16x8*>((char*)SB(b, h) + b_lane + (n * 2 + k) * 1024)
#define MMA(ai, bj, At_, Bt_) do { __builtin_amdgcn_s_setprio(1);                                     \
    _Pragma("unroll") for (int m = 0; m < 4; ++m) _Pragma("unroll") for (int n = 0; n < 2; ++n) _Pragma("unroll") for (int k = 0; k < 2; ++k) \
      acc[ai][bj][m][n] = __builtin_amdgcn_mfma_f32_16x16x32_bf16(Bt_[n][k], At_[m][k], acc[ai][bj][m][n], 0, 0, 0); \
    __builtin_amdgcn_s_setprio(0); } while (0)
#define WAIT_V(n) asm volatile("s_waitcnt vmcnt(" #n ")" ::: "memory")
#define WAIT_L(n) asm volatile("s_waitcnt lgkmcnt(" #n ")" ::: "memory")
#define BAR __builtin_amdgcn_s_barrier()
#define SCHED __builtin_amdgcn_sched_barrier(0)
  const int nM = NT / BM, nwg = nM * nN;
  const int wid = RAWTID >> 6, lane = RAWTID & 63, wr = wid >> 2, wc = wid & 3, fr = lane & 15, fq = lane >> 4;
  const int nt = K / BK;
  const float* adap = (const float*)(p.ws + OFF_ADAP);
  const int lane_off = (fr * 64 + fq * 16) ^ ((fr >> 3) << 5);
  const int a_lane = wr * 8192 + lane_off, b_lane = wc * 4096 + lane_off;
  const int lds_dst = __builtin_amdgcn_readfirstlane(RAWTID >> 6) * 1024;
  int offA0, offB0;
  { const int sb_ = lane * 16, swz_ = sb_ ^ (((sb_ >> 9) & 1) << 5);
    const int sr0 = (wid >> 1) * 16 + swz_ / 64, sc0 = (wid & 1) * 32 + (swz_ % 64) / 2;
    offA0 = sr0 * lda + sc0; offB0 = sr0 * ldb + sc0; }
  auto tile_coords = [&](int L_, int& brow_, int& bcol_, int& pn_) {
    int wgid = L_;
    { const int q = nwg / NXCD, rr = nwg % NXCD, xcd = wgid % NXCD, off = wgid / NXCD;
      wgid = (xcd < rr ? xcd * (q + 1) : rr * (q + 1) + (xcd - rr) * q) + off; }
    const int nig = WGM * nN, gid = wgid / nig, fm = gid * WGM, gsz = (nM - fm) < WGM ? (nM - fm) : WGM;
    const int pm_ = fm + ((wgid % nig) % gsz);
    pn_ = (wgid % nig) / gsz; brow_ = pm_ * BM; bcol_ = pn_ * BM;
  };
  int L = blockIdx.x;
  if (L >= nwg) return;
  int brow, bcol, pn;
  tile_coords(L, brow, bcol, pn);
  __syncthreads();
  {
    int offA = offA0, offB = offB0;
    asm volatile("" : "+v"(offA), "+v"(offB));
    STAGE_B(SB(0, 0), bcol, 0); STAGE_A(SA(0, 0), brow, 0);
    STAGE_B(SB(0, 1), bcol + HALF, 0); STAGE_A(SA(0, 1), brow + HALF, 0);
  }
  for (;;) {
    int offA = offA0, offB = offB0;
    asm volatile("" : "+v"(offA), "+v"(offB));
    f32x4 acc[2][2][4][2];
#pragma unroll
    for (int a = 0; a < 2; ++a)
#pragma unroll
      for (int b = 0; b < 2; ++b)
#pragma unroll
        for (int m = 0; m < 4; ++m)
#pragma unroll
          for (int n = 0; n < 2; ++n) acc[a][b][m][n] = (f32x4){0.f, 0.f, 0.f, 0.f};
    bf16x8 At[4][2], B0[2][2], B1[2][2];
    if (wr == 1) BAR;
    WAIT_V(4); BAR;
    STAGE_B(SB(1, 0), bcol, 1); STAGE_A(SA(1, 0), brow, 1); STAGE_B(SB(1, 1), bcol + HALF, 1);
    WAIT_V(6); BAR;
    for (int t = 0; t < nt - 2; t += 2) {
      LDB(B0, 0, 0); SCHED; LDA(At, 0, 0); STAGE_A(SA(1, 1), brow + HALF, t + 1);
      WAIT_L(8); BAR; WAIT_L(0); MMA(0, 0, At, B0); BAR; SCHED;
      LDB(B1, 0, 1); STAGE_B(SB(0, 0), bcol, t + 2);
      BAR; WAIT_L(0); MMA(0, 1, At, B1); BAR;
      LDA(At, 0, 1); STAGE_A(SA(0, 0), brow, t + 2);
      BAR; WAIT_L(0); MMA(1, 0, At, B0); BAR; SCHED;
      STAGE_B(SB(0, 1), bcol + HALF, t + 2);
      WAIT_V(6); BAR; MMA(1, 1, At, B1); BAR;
      LDB(B0, 1, 0); SCHED; LDA(At, 1, 0); STAGE_A(SA(0, 1), brow + HALF, t + 2);
      WAIT_L(8); BAR; WAIT_L(0); MMA(0, 0, At, B0); BAR; SCHED;
      LDB(B1, 1, 1); STAGE_B(SB(1, 0), bcol, t + 3);
      BAR; WAIT_L(0); MMA(0, 1, At, B1); BAR;
      LDA(At, 1, 1); STAGE_A(SA(1, 0), brow, t + 3);
      BAR; WAIT_L(0); MMA(1, 0, At, B0); BAR; SCHED;
      STAGE_B(SB(1, 1), bcol + HALF, t + 3);
      WAIT_V(6); BAR; MMA(1, 1, At, B1); BAR;
    }
    { LDB(B0, 0, 0); LDA(At, 0, 0); STAGE_A(SA(1, 1), brow + HALF, nt - 1);
      BAR; WAIT_L(0); MMA(0, 0, At, B0); BAR;
      LDB(B1, 0, 1); BAR; WAIT_L(0); MMA(0, 1, At, B1); BAR;
      LDA(At, 0, 1); WAIT_V(4); BAR; WAIT_L(0); MMA(1, 0, At, B0); MMA(1, 1, At, B1); BAR; }
    { LDB(B0, 1, 0); LDA(At, 1, 0); WAIT_V(2); BAR; WAIT_L(0); MMA(0, 0, At, B0); BAR;
      LDB(B1, 1, 1); WAIT_V(0); BAR; WAIT_L(0); MMA(0, 1, At, B1); BAR;
      LDA(At, 1, 1); BAR; WAIT_L(0); MMA(1, 0, At, B0); MMA(1, 1, At, B1); BAR; }
    if (wr == 0) BAR;
    const int Ln = L + gridDim.x;
    const bool more = Ln < nwg;
    int browN = 0, bcolN = 0, pnN = 0;
    if (more) {
      tile_coords(Ln, browN, bcolN, pnN);
      STAGE_B(SB(0, 0), bcolN, 0); STAGE_A(SA(0, 0), browN, 0);
      STAGE_B(SB(0, 1), bcolN + HALF, 0); STAGE_A(SA(0, 1), browN + HALF, 0);
    }
    __builtin_amdgcn_sched_barrier(0);
    int tid_e = RAWTID;
    asm volatile("" : "+v"(tid_e));
    const int wr_e = tid_e >> 8, wc_e = (tid_e >> 6) & 3, fr_e = tid_e & 15, fq_e = (tid_e >> 4) & 3;
    if constexpr (EPI == EPI_PROJ) {
      const size_t poff = pn < 6 ? OFF_R0 : (pn < 8 ? OFF_R2 : OFF_R3);
      const int ldo = pn < 6 ? 1536 : 512;
      const int cbase = pn < 6 ? bcol : (pn < 8 ? bcol - 1536 : bcol - 2048);
      u16* dst = (u16*)(p.ws + poff) + (size_t)brow * ldo + cbase;
      const int loff = (wr_e * 64 + fr_e) * ldo + wc_e * 32 + fq_e * 4;
#pragma unroll
      for (int ai = 0; ai < 2; ++ai)
#pragma unroll
        for (int m = 0; m < 4; ++m) {
          u16* rowp = dst + (ai * HALF + m * 16) * ldo + loff;
#pragma unroll
          for (int bj = 0; bj < 2; ++bj)
#pragma unroll
            for (int n = 0; n < 2; ++n) {
              const f32x4 v = acc[ai][bj][m][n];
              uint2 o; o.x = pack2(v[0], v[1]); o.y = pack2(v[2], v[3]);
              *(uint2*)(rowp + bj * HALF + n * 16) = o;
            }
        }
    } else if constexpr (EPI == EPI_RESID) {
      u16* dst = (u16*)(p.ws + (gate_chunk == 2 ? OFF_R1 : OFF_R2)) + (size_t)brow * 1024 + bcol;
      const int loff = (wr_e * 64 + fr_e) * 1024 + wc_e * 32 + fq_e * 4;
#pragma unroll
      for (int ai = 0; ai < 2; ++ai)
#pragma unroll
        for (int m = 0; m < 4; ++m) {
          u16* rowp = dst + (ai * HALF + m * 16) * 1024 + loff;
#pragma unroll
          for (int bj = 0; bj < 2; ++bj)
#pragma unroll
            for (int n = 0; n < 2; ++n) {
              const f32x4 v = acc[ai][bj][m][n];
              uint2 o; o.x = pack2(v[0], v[1]); o.y = pack2(v[2], v[3]);
              *(uint2*)(rowp + bj * HALF + n * 16) = o;
            }
        }
    } else {
      u16* act = (u16*)(p.ws + OFF_R0);
#pragma unroll
      for (int ai = 0; ai < 2; ++ai)
#pragma unroll
        for (int m = 0; m < 4; ++m) {
          u16* rowp = act + (size_t)(brow + ai * HALF + wr_e * 64 + m * 16 + fr_e) * DFF + pn * 128 + wc_e * 16 + fq_e * 4;
#pragma unroll
          for (int bj = 0; bj < 2; ++bj) {
            const f32x4 g = acc[ai][bj][m][0], u = acc[ai][bj][m][1];
            uint2 o;
            o.x = pack2(siluf(g[0]) * u[0], siluf(g[1]) * u[1]);
            o.y = pack2(siluf(g[2]) * u[2], siluf(g[3]) * u[3]);
            *(uint2*)(rowp + bj * 64) = o;
          }
        }
    }
    if (!more) break;
    L = Ln; brow = browN; bcol = bcolN; pn = pnN;
  }
#undef SA
#undef SB
#undef STAGE_
#undef STAGE_A
#undef STAGE_B
#undef LDA
#undef LDB
#undef MMA
#undef WAIT_V
#undef WAIT_L
#undef BAR
#undef SCHED
}

DI void ab_sliver(const Params& p, const int wid_s, char* smem_all) {
  const u16* hbuf = (const u16*)(p.ws + OFF_R1);
  const u16* wab = (const u16*)(p.ws + OFF_WIN) + (size_t)2560 * 1024;
  float* gb = (float*)(p.ws + OFF_GB);
  const int tid = RAWTID, wv = tid >> 6, lane = tid & 63, r = lane & 31, h = lane >> 5;
  const int hb_ = (gridDim.x == 256) ? (int)blockIdx.x - 192 : (int)gridDim.x - 1 - (int)blockIdx.x;
  const int nhb_ = (gridDim.x == 256) ? 64 : (int)gridDim.x;
  if (hb_ < 0 || hb_ * 8 >= 768) return;
  u16* sW = (u16*)smem_all;
  __syncthreads();
#pragma unroll
  for (int i = 0; i < 8; ++i) {
    const int ch = tid + 512 * i, row = ch >> 7, kc = ch & 127;
    *(uint4*)(sW + row * 1032 + kc * 8) = *(const uint4*)(wab + (size_t)row * 1024 + kc * 8);
  }
  __syncthreads();
  for (int wj = hb_ * 8 + wv; wj < 768; wj += nhb_ * 8) {
    const int row0 = wj * 32;
    f32x16 acc;
#pragma unroll
    for (int i = 0; i < 16; ++i) acc[i] = 0.f;
    u16* sAw = (u16*)(smem_all + 67584) + wv * 2304;
    const int lrow = lane >> 3, lkc = lane & 7;
    const u16* ag = hbuf + (size_t)(row0 + lrow) * 1024 + lkc * 8;
    const u16* bp = sW + r * 1032 + h * 8;
    uint4 c0 = *(const uint4*)(ag), c1 = *(const uint4*)(ag + 8 * 1024), c2 = *(const uint4*)(ag + 16 * 1024), c3 = *(const uint4*)(ag + 24 * 1024);
    for (int c = 0; c < 16; ++c) {
      *(uint4*)(sAw + lrow * 72 + lkc * 8) = c0;
      *(uint4*)(sAw + (lrow + 8) * 72 + lkc * 8) = c1;
      *(uint4*)(sAw + (lrow + 16) * 72 + lkc * 8) = c2;
      *(uint4*)(sAw + (lrow + 24) * 72 + lkc * 8) = c3;
      if (c + 1 < 16) {
        const u16* an = ag + (c + 1) * 64;
        c0 = *(const uint4*)(an); c1 = *(const uint4*)(an + 8 * 1024); c2 = *(const uint4*)(an + 16 * 1024); c3 = *(const uint4*)(an + 24 * 1024);
      }
#pragma unroll
      for (int s = 0; s < 4; ++s) {
        bf16x8 a = *(const bf16x8*)(sAw + r * 72 + s * 16 + h * 8);
        bf16x8 b = *(const bf16x8*)(bp + c * 64 + s * 16);
        acc = MFMA(b, a, acc);
      }
    }
    float* rowp = gb + (size_t)(row0 + r) * 16 + 4 * h;
    float4 o0 = {acc[0], acc[1], acc[2], acc[3]};
    float4 o1 = {acc[4], acc[5], acc[6], acc[7]};
    *(float4*)(rowp) = o0;
    *(float4*)(rowp + 8) = o1;
  }
}

DI void phase_conv_pool(const Params& p, const int wid_s, int l, char* smem) {
  const u16* raw = (const u16*)(p.ws + OFF_R0);
  u16* qkv2 = (u16*)(p.ws + OFF_R1);
  const u16* pool = (const u16*)(p.ws + OFF_R3);
  u16* pm = (u16*)(p.ws + OFF_R4);
  float* s1 = (float*)smem;
  int tid_ = VTID; asm volatile("" : "+v"(tid_)); const int tid = tid_, lane = tid & 63, wv = tid >> 6;
  for (int it = VB; it < 1152 + 1024 + 512; it += VGRID) {
    if (it < 1152) {
      const int chunk = it / 3, sec = it % 3;
      const int t0 = chunk * 64;
      int seq_lo, seq_hi;
      if (t0 < NCTX) { seq_lo = t0 & ~255; seq_hi = seq_lo + 256; } else { seq_lo = NCTX + ((t0 - NCTX) & ~2047); seq_hi = seq_lo + 2048; }
      const int cb = sec * 512 + lane * 8;
      float w[5][8];
#pragma unroll
      for (int j = 0; j < 5; ++j)
#pragma unroll
        for (int e = 0; e < 8; ++e) w[j][e] = p.conv_w[((size_t)l * 5 + j) * 1536 + cb + e];
      uint4 rwa[20];
#pragma unroll
      for (int j = 0; j < 20; ++j) {
        int ts = t0 + wv * 16 + j - 2;
        rwa[j] = (ts >= seq_lo && ts < seq_hi) ? *(const uint4*)(raw + (size_t)ts * 1536 + cb) : make_uint4(0u, 0u, 0u, 0u);
      }
#pragma unroll
      for (int tq = 0; tq < 16; tq += 4) {
        const int tb = t0 + wv * 16 + tq;
        const uint4* rw = rwa + tq;
#pragma unroll
        for (int u = 0; u < 4; ++u) {
          float a[8];
#pragma unroll
          for (int e = 0; e < 8; ++e) a[e] = 0.f;
#pragma unroll
          for (int j = 0; j < 5; ++j) {
            const uint4 v = rw[u + j];
            a[0] += w[j][0] * bflo(v.x); a[1] += w[j][1] * bfhi(v.x);
            a[2] += w[j][2] * bflo(v.y); a[3] += w[j][3] * bfhi(v.y);
            a[4] += w[j][4] * bflo(v.z); a[5] += w[j][5] * bfhi(v.z);
            a[6] += w[j][6] * bflo(v.w); a[7] += w[j][7] * bfhi(v.w);
          }
          float ss = 0.f;
#pragma unroll
          for (int e = 0; e < 8; ++e) { a[e] = siluf(a[e]); ss += a[e] * a[e]; }
          float scl = 1.f;
          if (sec < 2) {
            ss += __shfl_xor(ss, 1); ss += __shfl_xor(ss, 2); ss += __shfl_xor(ss, 4); ss += __shfl_xor(ss, 8);
            scl = rsqrtf(ss + EPSF);
            if (sec == 0) scl *= 0.08838834764831845f;
          }
          uint4 o;
          o.x = pack2(a[0] * scl, a[1] * scl); o.y = pack2(a[2] * scl, a[3] * scl);
          o.z = pack2(a[4] * scl, a[5] * scl); o.w = pack2(a[6] * scl, a[7] * scl);
          *(uint4*)(qkv2 + (size_t)(tb + u) * 1536 + cb) = o;
        }
      }
    } else if (it < 1152 + 1024) {
      const int j = it - 1152;
      const int gi = (j < 512) ? (j & 3) : 3 - (j & 3), rr = (j >> 2) & 31, b = j >> 7;
      const int win = 2 << gi;
      int rlo = rr - win / 2; if (rlo < 0) rlo = 0;
      int rhi = rr - win / 2 + win; if (rhi > 32) rhi = 32;
      const int tbase = NCTX + b * 2048;
      __syncthreads();
      {
        float a[4][8];
#pragma unroll
        for (int i = 0; i < 4; ++i)
#pragma unroll
          for (int e = 0; e < 8; ++e) a[i][e] = 0.f;
        for (int r2 = rlo; r2 < rhi; r2 += 4) {
          uint4 x[4][4];
#pragma unroll
          for (int k = 0; k < 4; ++k)
#pragma unroll
            for (int i = 0; i < 4; ++i) {
              const int v = tid + 256 * i, col = v >> 4, cv = v & 15;
              x[k][i] = (r2 + k < rhi) ? *(const uint4*)(pool + (size_t)(tbase + (r2 + k) * 64 + col) * 512 + gi * 128 + cv * 8)
                                       : make_uint4(0u, 0u, 0u, 0u);
            }
#pragma unroll
          for (int k = 0; k < 4; ++k)
#pragma unroll
            for (int i = 0; i < 4; ++i) {
              a[i][0] += bflo(x[k][i].x); a[i][1] += bfhi(x[k][i].x); a[i][2] += bflo(x[k][i].y); a[i][3] += bfhi(x[k][i].y);
              a[i][4] += bflo(x[k][i].z); a[i][5] += bfhi(x[k][i].z); a[i][6] += bflo(x[k][i].w); a[i][7] += bfhi(x[k][i].w);
            }
        }
#pragma unroll
        for (int i = 0; i < 4; ++i) {
          const int v = tid + 256 * i, col = v >> 4, cv = v & 15;
          *(float4*)(s1 + col * 128 + cv * 8) = make_float4(a[i][0], a[i][1], a[i][2], a[i][3]);
          *(float4*)(s1 + col * 128 + cv * 8 + 4) = make_float4(a[i][4], a[i][5], a[i][6], a[i][7]);
        }
      }
      __syncthreads();
#pragma unroll
      for (int i = 0; i < 4; ++i) {
        int v = tid + 256 * i, col = v >> 4, cv = v & 15;
        int clo = col - win / 2; if (clo < 0) clo = 0;
        int chi = col - win / 2 + win; if (chi > 64) chi = 64;
        float a[8];
#pragma unroll
        for (int e = 0; e < 8; ++e) a[e] = 0.f;
        for (int c2 = clo; c2 < chi; c2 += 4) {
          float4 x0[4], x1[4];
#pragma unroll
          for (int k = 0; k < 4; ++k) {
            const int cc = (c2 + k < chi) ? c2 + k : clo;
            x0[k] = *(const float4*)(s1 + cc * 128 + cv * 8);
            x1[k] = *(const float4*)(s1 + cc * 128 + cv * 8 + 4);
          }
#pragma unroll
          for (int k = 0; k < 4; ++k) {
            const float m = (c2 + k < chi) ? 1.f : 0.f;
            a[0] += m * x0[k].x; a[1] += m * x0[k].y; a[2] += m * x0[k].z; a[3] += m * x0[k].w;
            a[4] += m * x1[k].x; a[5] += m * x1[k].y; a[6] += m * x1[k].z; a[7] += m * x1[k].w;
          }
        }
        const float inv = __builtin_amdgcn_rcpf((float)((rhi - rlo) * (chi - clo)));
        const size_t off = (size_t)(tbase + rr * 64 + col) * 512 + gi * 128 + cv * 8;
        uint4 u = *(const uint4*)(pool + off);
        uint4 o;
        o.x = pack2(a[0] * inv - bflo(u.x), a[1] * inv - bfhi(u.x));
        o.y = pack2(a[2] * inv - bflo(u.y), a[3] * inv - bfhi(u.y));
        o.z = pack2(a[4] * inv - bflo(u.z), a[5] * inv - bfhi(u.z));
        o.w = pack2(a[6] * inv - bflo(u.w), a[7] * inv - bfhi(u.w));
        *(uint4*)(pm + off) = o;
      }
    } else {
      const int j = it - 1152 - 1024;
      const int gi = j & 3, chunk = j >> 2;
      const int win = 2 << gi;
      const int seqbase = (chunk >> 2) * 256, pos0 = (chunk & 3) * 64;
#pragma unroll
      for (int i = 0; i < 4; ++i) {
        int v = tid + 256 * i, col = v >> 4, cv = v & 15;
        int pos = pos0 + col;
        int lo = pos - win / 2; if (lo < 0) lo = 0;
        int hi = pos - win / 2 + win; if (hi > 256) hi = 256;
        float a[8];
#pragma unroll
        for (int e = 0; e < 8; ++e) a[e] = 0.f;
        for (int p2 = lo; p2 < hi; p2 += 8) {
          uint4 x[8];
#pragma unroll
          for (int k = 0; k < 8; ++k)
            x[k] = (p2 + k < hi) ? *(const uint4*)(pool + (size_t)(seqbase + p2 + k) * 512 + gi * 128 + cv * 8) : make_uint4(0u, 0u, 0u, 0u);
#pragma unroll
          for (int k = 0; k < 8; ++k) {
            a[0] += bflo(x[k].x); a[1] += bfhi(x[k].x); a[2] += bflo(x[k].y); a[3] += bfhi(x[k].y);
            a[4] += bflo(x[k].z); a[5] += bfhi(x[k].z); a[6] += bflo(x[k].w); a[7] += bfhi(x[k].w);
          }
        }
        const float inv = __builtin_amdgcn_rcpf((float)(hi - lo));
        const size_t off = (size_t)(seqbase + pos) * 512 + gi * 128 + cv * 8;
        uint4 u = *(const uint4*)(pool + off);
        uint4 o;
        o.x = pack2(a[0] * inv - bflo(u.x), a[1] * inv - bfhi(u.x));
        o.y = pack2(a[2] * inv - bflo(u.y), a[3] * inv - bfhi(u.y));
        o.z = pack2(a[4] * inv - bflo(u.z), a[5] * inv - bfhi(u.z));
        o.w = pack2(a[6] * inv - bflo(u.w), a[7] * inv - bfhi(u.w));
        *(uint4*)(pm + off) = o;
      }
    }
  }
}

DI void phase_intra(const Params& p, const int wid_s, int l, char* smem) {
  u16* sQ = (u16*)smem;
  u16* sK = sQ + 64 * 136;
  float* sL = (float*)smem;
  float* sGkk = (float*)(smem + 34816);
  float* sGqk = sGkk + 64 * 65;
  float* sgc = (float*)(smem + 68096);
  float* sbt = sgc + 128;
  const u16* qkv2 = (const u16*)(p.ws + OFF_R1);
  const float* gb = (const float*)(p.ws + OFF_GB);
  u16* Tout = (u16*)(p.ws + OFF_T);
  u16* Aout = (u16*)(p.ws + OFF_ATT);
  float* gcbuf = (float*)(p.ws + OFF_GC);
  int tid_ = VTID; asm volatile("" : "+v"(tid_)); const int tid = tid_, lane = tid & 63, wv = tid >> 6, r = lane & 31, h = lane >> 5;
  for (int it = VB; it < 1536; it += VGRID) {
    const int chunk = it >> 2, hd = it & 3;
    const int t0 = chunk * 64;
    __syncthreads();
#pragma unroll
    for (int i = 0; i < 4; ++i) {
      int ch = tid + 256 * i, row = ch >> 4, kc = ch & 15;
      uint4 vq = *(const uint4*)(qkv2 + (size_t)(t0 + row) * 1536 + hd * 128 + kc * 8);
      uint4 vk = *(const uint4*)(qkv2 + (size_t)(t0 + row) * 1536 + 512 + hd * 128 + kc * 8);
      *(uint4*)(sQ + row * 136 + kc * 8) = vq;
      *(uint4*)(sK + row * 136 + kc * 8) = vk;
    }
    if (tid < 128) {
      int d = tid >> 6, i = tid & 63;
      int tok = t0 + (d ? 63 - i : i);
      sbt[tid] = __builtin_amdgcn_rcpf(1.f + __expf(-gb[(size_t)tok * 16 + d * 4 + hd]));
      const float xx = gb[(size_t)tok * 16 + 8 + d * 4 + hd] + p.dt_bias[(l * 2 + d) * 4 + hd];
      const float sp = (xx > 20.f) ? xx : log1pf(__expf(xx));
      sgc[tid] = -__expf(p.a_log[(l * 2 + d) * 4 + hd]) * sp;
    }
    __syncthreads();
    if (tid < 128) {
      float a = sgc[tid];
#pragma unroll
      for (int o = 1; o < 64; o <<= 1) { const float t = __shfl_up(a, o); if (lane >= o) a += t; }
      sgc[tid] = a;
    }
    {
      const int mt = wv >> 1, nt = wv & 1;
      f32x16 akk, aqk;
#pragma unroll
      for (int i = 0; i < 16; ++i) { akk[i] = 0.f; aqk[i] = 0.f; }
#pragma unroll
      for (int s = 0; s < 8; ++s) {
        bf16x8 bk = *(const bf16x8*)(sK + (nt * 32 + r) * 136 + s * 16 + h * 8);
        bf16x8 ak = *(const bf16x8*)(sK + (mt * 32 + r) * 136 + s * 16 + h * 8);
        bf16x8 aq = *(const bf16x8*)(sQ + (mt * 32 + r) * 136 + s * 16 + h * 8);
        akk = MFMA(ak, bk, akk);
        aqk = MFMA(aq, bk, aqk);
      }
#pragma unroll
      for (int i = 0; i < 16; ++i) {
        int row = mt * 32 + crow(i, h), col = nt * 32 + r;
        sGkk[row * 65 + col] = akk[i];
        sGqk[row * 65 + col] = aqk[i];
      }
    }
    __syncthreads();
    for (int e = tid; e < 2 * 64 * 64; e += 256) {
      int d = e >> 12, i = (e >> 6) & 63, j = e & 63;
      int ti = d ? 63 - i : i, tj = d ? 63 - j : j;
      float dec = (i >= j) ? __expf(sgc[d * 64 + i] - sgc[d * 64 + j]) : 0.f;
      float Lv = (i > j) ? sbt[d * 64 + i] * sGkk[ti * 65 + tj] * dec : 0.f;
      sL[e] = Lv;
      Aout[((size_t)it * 2 + d) * 4096 + i * 64 + j] = f2bf(sGqk[ti * 65 + tj] * dec);
    }
    if (tid < 128) gcbuf[((size_t)it * 2 + (tid >> 6)) * 64 + (tid & 63)] = sgc[tid];
    __syncthreads();
    if (wv < 2) {
      const int d = wv;
      const float* L = sL + d * 4096;
      float x[64];
#pragma unroll
      for (int i = 0; i < 64; ++i) x[i] = 0.f;
#pragma unroll
      for (int i = 0; i < 64; ++i) {
        float a0 = (lane == i) ? 1.f : 0.f, a1 = 0.f, a2 = 0.f, a3 = 0.f;
#pragma unroll
        for (int j4 = 0; j4 < (i + 3) / 4; ++j4) {
          const float4 lv = *(const float4*)(L + i * 64 + j4 * 4);
          a0 -= lv.x * x[j4 * 4 + 0]; a1 -= lv.y * x[j4 * 4 + 1]; a2 -= lv.z * x[j4 * 4 + 2]; a3 -= lv.w * x[j4 * 4 + 3];
        }
        x[i] = (a0 + a1) + (a2 + a3);
      }
      u16* To = Tout + ((size_t)it * 2 + d) * 4096;
#pragma unroll
      for (int i = 0; i < 64; ++i) To[i * 64 + lane] = f2bf(x[i]);
    }
  }
}

DI bf16x8 ldA_perm(const u16* rowp, int s, int h) {
  s16x4 lo = *(const s16x4*)(rowp + 16 * s + 4 * h);
  s16x4 hi = *(const s16x4*)(rowp + 16 * s + 8 + 4 * h);
  return __builtin_shufflevector(lo, hi, 0, 1, 2, 3, 4, 5, 6, 7);
}
DI bf16x8 pack_step(const f32x16& x, int s) {
  unsigned a = pack2(x[8 * s + 0], x[8 * s + 1]), b = pack2(x[8 * s + 2], x[8 * s + 3]);
  unsigned c = pack2(x[8 * s + 4], x[8 * s + 5]), d = pack2(x[8 * s + 6], x[8 * s + 7]);
  uint4 u = {a, b, c, d};
  return __builtin_bit_cast(bf16x8, u);
}

DI void phase_scan(const Params& p, const int wid_s, int l, char* smem) {
  u16* sQ = (u16*)smem;
  u16* sK = sQ + 64 * 136;
  u16* sKT = sK + 64 * 136;
  u16* sT = sKT + 128 * 72;
  u16* sAt = sT + 64 * 72;
  float* sgc = (float*)(smem + 71680);
  float* sbt = sgc + 64;
  float* sD = sgc + 128;
  const u16* qkv2 = (const u16*)(p.ws + OFF_R1);
  const float* gb = (const float*)(p.ws + OFF_GB);
  const u16* Tbuf = (const u16*)(p.ws + OFF_T);
  const u16* Abuf = (const u16*)(p.ws + OFF_ATT);
  const float* gcbuf = (const float*)(p.ws + OFF_GC);
  u16* of = (u16*)(p.ws + OFF_R3);
  u16* ob = (u16*)(p.ws + OFF_OB);
  const int tid0 = VTID;
  for (int it = 64 + (VB - 128); it < 320; it += VGRID) {
    int tid = tid0;
    asm volatile("" : "+v"(tid));
    int wv = tid >> 6, r = tid & 31, h = (tid >> 5) & 1;
    int seq, hd, d, nchunk, chunk0; bool is_lat;
    if (it < 64) { is_lat = true; seq = it >> 3; hd = (it >> 1) & 3; d = it & 1; nchunk = 32; chunk0 = 128 + seq * 32; }
    else { int j = it - 64; is_lat = false; seq = j >> 3; hd = (j >> 1) & 3; d = j & 1; nchunk = 4; chunk0 = seq * 4; }
    u16* odst = d ? ob : of;
    f32x16 S[4];
    if (is_lat) {
      const float* s0 = p.state_delta + ((((size_t)seq * 2 + l) * 2 + d) * 4 + hd) * 16384;
#pragma unroll
      for (int kt = 0; kt < 4; ++kt)
#pragma unroll
        for (int i = 0; i < 16; ++i) S[kt][i] = s0[(kt * 32 + crow(i, h)) * 128 + wv * 32 + r];
    } else {
#pragma unroll
      for (int kt = 0; kt < 4; ++kt)
#pragma unroll
        for (int i = 0; i < 16; ++i) S[kt][i] = 0.f;
    }
    uint4 pq0, pq1, pq2, pq3, pk0, pk1, pk2, pk3, pt0, pt1, pa0, pa1;
    float pgc = 0.f, pbt = 0.f;
    f32x16 vv[2];
#define PF1(i)                                                                                       \
    {                                                                                                \
      const int ch = tid + 256 * i, row = ch >> 4, kc = ch & 15;                                     \
      const int tok = pt0_ + (d ? 63 - row : row);                                                   \
      pq##i = *(const uint4*)(qkv2 + (size_t)tok * 1536 + hd * 128 + kc * 8);                        \
      pk##i = *(const uint4*)(qkv2 + (size_t)tok * 1536 + 512 + hd * 128 + kc * 8);                  \
    }
#define PF_LOAD(nn)                                                                                  \
    do {                                                                                             \
      const int pchunk = chunk0 + (d ? nchunk - 1 - (nn) : (nn));                                    \
      const int pt0_ = pchunk * 64;                                                                  \
      const size_t pcix = ((size_t)pchunk * 4 + hd) * 2 + d;                                         \
      PF1(0) PF1(1) PF1(2) PF1(3)                                                                    \
      {                                                                                              \
        const int row = tid >> 3, cc = tid & 7;                                                      \
        pt0 = *(const uint4*)(Tbuf + pcix * 4096 + row * 64 + cc * 8);                               \
        pt1 = *(const uint4*)(Tbuf + pcix * 4096 + (row + 32) * 64 + cc * 8);                        \
        pa0 = *(const uint4*)(Abuf + pcix * 4096 + row * 64 + cc * 8);                               \
        pa1 = *(const uint4*)(Abuf + pcix * 4096 + (row + 32) * 64 + cc * 8);                        \
      }                                                                                              \
      if (tid < 64) {                                                                                \
        pgc = gcbuf[pcix * 64 + tid];                                                                \
        pbt = __builtin_amdgcn_rcpf(1.f + __expf(-gb[(size_t)(pt0_ + (d ? 63 - tid : tid)) * 16 + d * 4 + hd]));    \
      }                                                                                              \
    } while (0)
#define VV_LOAD(nn)                                                                                  \
    do {                                                                                             \
      const int vchunk = chunk0 + (d ? nchunk - 1 - (nn) : (nn));                                    \
      const int vt0 = vchunk * 64;                                                                   \
      _Pragma("unroll") for (int mt = 0; mt < 2; ++mt)                                               \
      _Pragma("unroll") for (int i = 0; i < 16; ++i) {                                               \
        const int pos = mt * 32 + crow(i, h);                                                        \
        const int tok = vt0 + (d ? 63 - pos : pos);                                                  \
        vv[mt][i] = bf2f(qkv2[(size_t)tok * 1536 + 1024 + hd * 128 + wv * 32 + r]);                  \
      }                                                                                              \
    } while (0)
#define PS1(i)                                                                                       \
    {                                                                                                \
      const int ch = tid + 256 * i, row = ch >> 4, kc = ch & 15;                                     \
      *(uint4*)(sQ + row * 136 + kc * 8) = pq##i;                                                    \
      *(uint4*)(sK + row * 136 + kc * 8) = pk##i;                                                    \
      u16* kt_ = sKT + (kc * 8) * 72 + (row ^ (4 * kc));      \
      kt_[0 * 72] = (u16)(pk##i.x & 0xffff); kt_[1 * 72] = (u16)(pk##i.x >> 16);                     \
      kt_[2 * 72] = (u16)(pk##i.y & 0xffff); kt_[3 * 72] = (u16)(pk##i.y >> 16);                     \
      kt_[4 * 72] = (u16)(pk##i.z & 0xffff); kt_[5 * 72] = (u16)(pk##i.z >> 16);                     \
      kt_[6 * 72] = (u16)(pk##i.w & 0xffff); kt_[7 * 72] = (u16)(pk##i.w >> 16);                     \
    }
    for (int n = 0; n < nchunk; ++n) {
      const int chunk = chunk0 + (d ? nchunk - 1 - n : n);
      const int t0 = chunk * 64;
      __syncthreads();
      asm volatile("" : "+v"(tid));
      wv = tid >> 6; r = tid & 31; h = (tid >> 5) & 1;
      PF_LOAD(n);
      VV_LOAD(n);
      PS1(0) PS1(1) PS1(2) PS1(3)
      {
        const int row = tid >> 3, cc = tid & 7;
        *(uint4*)(sT + row * 72 + cc * 8) = pt0;
        *(uint4*)(sT + (row + 32) * 72 + cc * 8) = pt1;
        *(uint4*)(sAt + row * 72 + cc * 8) = pa0;
        *(uint4*)(sAt + (row + 32) * 72 + cc * 8) = pa1;
      }
      if (tid < 64) { const float gl = __shfl(pgc, 63); sgc[tid] = __expf(pgc); sD[tid] = __expf(gl - pgc); sbt[tid] = pbt; }
      __syncthreads();
      f32x16 VN[2];
      {
        f32x16 KS[2];
#pragma unroll
        for (int mt = 0; mt < 2; ++mt)
#pragma unroll
          for (int i = 0; i < 16; ++i) KS[mt][i] = 0.f;
#pragma unroll
        for (int kt = 0; kt < 4; ++kt)
#pragma unroll
          for (int s = 0; s < 2; ++s) {
            const bf16x8 sb = pack_step(S[kt], s);
#pragma unroll
            for (int mt = 0; mt < 2; ++mt) {
              bf16x8 ak = ldA_perm(sK + (mt * 32 + r) * 136 + kt * 32, s, h);
              KS[mt] = MFMA(ak, sb, KS[mt]);
            }
            __builtin_amdgcn_sched_barrier(0);
          }
        bf16x8 Rb[2][2];
#pragma unroll
        for (int mt = 0; mt < 2; ++mt) {
          f32x16 R;
#pragma unroll
          for (int i = 0; i < 16; ++i) {
            int pos = mt * 32 + crow(i, h);
            R[i] = sbt[pos] * (vv[mt][i] - sgc[pos] * KS[mt][i]);
          }
          Rb[mt][0] = pack_step(R, 0); Rb[mt][1] = pack_step(R, 1);
        }
#pragma unroll
        for (int mo = 0; mo < 2; ++mo) {
#pragma unroll
          for (int i = 0; i < 16; ++i) VN[mo][i] = 0.f;
#pragma unroll
          for (int mt = 0; mt < 2; ++mt)
#pragma unroll
            for (int s = 0; s < 2; ++s) {
              bf16x8 at = ldA_perm(sT + (mo * 32 + r) * 72 + mt * 32, s, h);
              VN[mo] = MFMA(at, Rb[mt][s], VN[mo]);
            }
        }
      }
      __builtin_amdgcn_sched_barrier(0);
      bf16x8 Vb[2][2];
#pragma unroll
      for (int mt = 0; mt < 2; ++mt) { Vb[mt][0] = pack_step(VN[mt], 0); Vb[mt][1] = pack_step(VN[mt], 1); }
      asm volatile("" : "+v"(tid));
      wv = tid >> 6; r = tid & 31; h = (tid >> 5) & 1;
#pragma unroll
      for (int mo = 0; mo < 2; ++mo) {
        f32x16 O;
#pragma unroll
        for (int i = 0; i < 16; ++i) O[i] = 0.f;
#pragma unroll
        for (int kt = 0; kt < 4; ++kt)
#pragma unroll
          for (int s = 0; s < 2; ++s) {
            const bf16x8 sb = pack_step(S[kt], s);
            bf16x8 aq = ldA_perm(sQ + (mo * 32 + r) * 136 + kt * 32, s, h);
            O = MFMA(aq, sb, O);
          }
#pragma unroll
        for (int i = 0; i < 16; ++i) { int pos = mo * 32 + crow(i, h); O[i] *= sgc[pos]; }
#pragma unroll
        for (int mt = 0; mt < 2; ++mt)
#pragma unroll
          for (int s = 0; s < 2; ++s) {
            bf16x8 aa = ldA_perm(sAt + (mo * 32 + r) * 72 + mt * 32, s, h);
            O = MFMA(aa, Vb[mt][s], O);
          }
#pragma unroll
        for (int i = 0; i < 16; ++i) {
          int pos = mo * 32 + crow(i, h);
          int tok = t0 + (d ? 63 - pos : pos);
          odst[(size_t)tok * 512 + hd * 128 + wv * 32 + r] = f2bf(O[i]);
        }
        __builtin_amdgcn_sched_barrier(0);
      }
      const float eg = sgc[63];
#pragma unroll
      for (int mt = 0; mt < 2; ++mt) {
#pragma unroll
        for (int i = 0; i < 16; ++i) { int pos = mt * 32 + crow(i, h); VN[mt][i] *= sD[pos]; }
        Vb[mt][0] = pack_step(VN[mt], 0); Vb[mt][1] = pack_step(VN[mt], 1);
      }
#pragma unroll
      for (int kt = 0; kt < 4; ++kt) {
#pragma unroll
        for (int i = 0; i < 16; ++i) S[kt][i] *= eg;
#pragma unroll
        for (int mt = 0; mt < 2; ++mt)
#pragma unroll
          for (int s = 0; s < 2; ++s) {
            const u16* krow_ = sKT + (kt * 32 + r) * 72;
            const int gsw = 4 * ((kt * 4 + (r >> 3)) & 15);
            s16x4 klo = *(const s16x4*)(krow_ + ((mt * 32 + 16 * s + 4 * h) ^ gsw));
            s16x4 khi = *(const s16x4*)(krow_ + ((mt * 32 + 16 * s + 8 + 4 * h) ^ gsw));
            bf16x8 ak = __builtin_shufflevector(klo, khi, 0, 1, 2, 3, 4, 5, 6, 7);
            S[kt] = MFMA(ak, Vb[mt][s], S[kt]);
          }
        __builtin_amdgcn_sched_barrier(0);
      }
    }
#undef PF1
#undef PF_LOAD
#undef VV_LOAD
#undef PS1
    if (!is_lat) {
      float* so = p.out + (size_t)NT * DM + ((((size_t)seq * 2 + l) * 2 + d) * 4 + hd) * 16384;
#pragma unroll
      for (int kt = 0; kt < 4; ++kt)
#pragma unroll
        for (int i = 0; i < 16; ++i) so[(kt * 32 + crow(i, h)) * 128 + wv * 32 + r] = S[kt][i];
    }
  }
}

DI void phase_scan_lat8(const Params& p, const int wid_s, int l, char* smem_all) {
#define LBAR() do { asm volatile("s_waitcnt lgkmcnt(0)" ::: "memory"); __builtin_amdgcn_s_barrier(); asm volatile("" ::: "memory"); } while (0)
  const u16* qkv2 = (const u16*)(p.ws + OFF_R1);
  const float* gb = (const float*)(p.ws + OFF_GB);
  const u16* Tbuf = (const u16*)(p.ws + OFF_T);
  const u16* Abuf = (const u16*)(p.ws + OFF_ATT);
  const float* gcbuf = (const float*)(p.ws + OFF_GC);
  u16* of = (u16*)(p.ws + OFF_R3);
  u16* ob = (u16*)(p.ws + OFF_OB);
  const int it = blockIdx.x;
  if (it >= 64) return;
  const int seq = it >> 3, hd = (it >> 1) & 3, d = it & 1, nchunk = 32, chunk0 = 128 + seq * 32;
  u16* odst = d ? ob : of;
  int tid = RAWTID & 255;
#define PF1(i)                                                                                       \
    {                                                                                                \
      const int ch = tid + 256 * i, row = ch >> 4, kc = ch & 15;                                     \
      const int tok = pt0_ + (d ? 63 - row : row);                                                   \
      pq##i = *(const uint4*)(qkv2 + (size_t)tok * 1536 + hd * 128 + kc * 8);                        \
      pk##i = *(const uint4*)(qkv2 + (size_t)tok * 1536 + 512 + hd * 128 + kc * 8);                  \
    }
#define PF_LOAD(nn)                                                                                  \
    do {                                                                                             \
      const int pchunk = chunk0 + (d ? nchunk - 1 - (nn) : (nn));                                    \
      const int pt0_ = pchunk * 64;                                                                  \
      const size_t pcix = ((size_t)pchunk * 4 + hd) * 2 + d;                                         \
      PF1(0) PF1(1) PF1(2) PF1(3)                                                                    \
      {                                                                                              \
        const int row = tid >> 3, cc = tid & 7;                                                      \
        pt0 = *(const uint4*)(Tbuf + pcix * 4096 + row * 64 + cc * 8);                               \
        pt1 = *(const uint4*)(Tbuf + pcix * 4096 + (row + 32) * 64 + cc * 8);                        \
        pa0 = *(const uint4*)(Abuf + pcix * 4096 + row * 64 + cc * 8);                               \
        pa1 = *(const uint4*)(Abuf + pcix * 4096 + (row + 32) * 64 + cc * 8);                        \
      }                                                                                              \
      if (tid < 64) {                                                                                \
        pgc = gcbuf[pcix * 64 + tid];                                                                \
        pbt = __builtin_amdgcn_rcpf(1.f + __expf(-gb[(size_t)(pt0_ + (d ? 63 - tid : tid)) * 16 + d * 4 + hd]));    \
      }                                                                                              \
    } while (0)
#define VV_LOAD(nn)                                                                                  \
    do {                                                                                             \
      const int vchunk = chunk0 + (d ? nchunk - 1 - (nn) : (nn));                                    \
      const int vt0 = vchunk * 64;                                                                   \
      _Pragma("unroll") for (int mt = 0; mt < 2; ++mt)                                               \
      _Pragma("unroll") for (int i = 0; i < 16; ++i) {                                               \
        const int pos = mt * 32 + crow(i, h);                                                        \
        const int tok = vt0 + (d ? 63 - pos : pos);                                                  \
        vv[mt][i] = bf2f(qkv2[(size_t)tok * 1536 + 1024 + hd * 128 + wv * 32 + r]);                  \
      }                                                                                              \
    } while (0)
#define PS1(i)                                                                                       \
    {                                                                                                \
      const int ch = tid + 256 * i, row = ch >> 4, kc = ch & 15;                                     \
      *(uint4*)(sQ + row * 136 + kc * 8) = pq##i;                                                    \
      *(uint4*)(sK + row * 136 + kc * 8) = pk##i;                                                    \
      u16* kt_ = sKT + (kc * 8) * 72 + (row ^ (4 * kc));      \
      kt_[0 * 72] = (u16)(pk##i.x & 0xffff); kt_[1 * 72] = (u16)(pk##i.x >> 16);                     \
      kt_[2 * 72] = (u16)(pk##i.y & 0xffff); kt_[3 * 72] = (u16)(pk##i.y >> 16);                     \
      kt_[4 * 72] = (u16)(pk##i.z & 0xffff); kt_[5 * 72] = (u16)(pk##i.z >> 16);                     \
      kt_[6 * 72] = (u16)(pk##i.w & 0xffff); kt_[7 * 72] = (u16)(pk##i.w >> 16);                     \
    }

#define XPF1(P, i)                                                                                   \
    {                                                                                                \
      const int ch = tid + 256 * i, row = ch >> 4, kc = ch & 15;                                     \
      const int tok = pt0_ + (d ? 63 - row : row);                                                   \
      P##q##i = *(const uint4*)(qkv2 + (size_t)tok * 1536 + hd * 128 + kc * 8);                      \
      P##k##i = *(const uint4*)(qkv2 + (size_t)tok * 1536 + 512 + hd * 128 + kc * 8);                \
    }
#define XPF_LOAD(P, nn)                                                                              \
    do {                                                                                             \
      const int pchunk = chunk0 + (d ? nchunk - 1 - (nn) : (nn));                                    \
      const int pt0_ = pchunk * 64;                                                                  \
      const size_t pcix = ((size_t)pchunk * 4 + hd) * 2 + d;                                         \
      XPF1(P, 0) XPF1(P, 1) XPF1(P, 2) XPF1(P, 3)                                                    \
      {                                                                                              \
        const int row = tid >> 3, cc = tid & 7;                                                      \
        P##t0 = *(const uint4*)(Tbuf + pcix * 4096 + row * 64 + cc * 8);                             \
        P##t1 = *(const uint4*)(Tbuf + pcix * 4096 + (row + 32) * 64 + cc * 8);                      \
        P##a0 = *(const uint4*)(Abuf + pcix * 4096 + row * 64 + cc * 8);                             \
        P##a1 = *(const uint4*)(Abuf + pcix * 4096 + (row + 32) * 64 + cc * 8);                      \
      }                                                                                              \
      if (tid < 64) {                                                                                \
        P##gc = gcbuf[pcix * 64 + tid];                                                              \
        P##bt = __builtin_amdgcn_rcpf(1.f + __expf(-gb[(size_t)(pt0_ + (d ? 63 - tid : tid)) * 16 + d * 4 + hd]));  \
      }                                                                                              \
    } while (0)
#define XPS1(P, i)                                                                                   \
    {                                                                                                \
      const int ch = tid + 256 * i, row = ch >> 4, kc = ch & 15;                                     \
      *(uint4*)(sQ + row * 136 + kc * 8) = P##q##i;                                                  \
      *(uint4*)(sK + row * 136 + kc * 8) = P##k##i;                                                  \
      u16* kt_ = sKT + (kc * 8) * 72 + (row ^ (4 * kc));                                             \
      kt_[0 * 72] = (u16)(P##k##i.x & 0xffff); kt_[1 * 72] = (u16)(P##k##i.x >> 16);                 \
      kt_[2 * 72] = (u16)(P##k##i.y & 0xffff); kt_[3 * 72] = (u16)(P##k##i.y >> 16);                 \
      kt_[4 * 72] = (u16)(P##k##i.z & 0xffff); kt_[5 * 72] = (u16)(P##k##i.z >> 16);                 \
      kt_[6 * 72] = (u16)(P##k##i.w & 0xffff); kt_[7 * 72] = (u16)(P##k##i.w >> 16);                 \
    }
#define XSTORE(P, bufidx)                                                                            \
    do {                                                                                             \
      char* bb = smem_all + (bufidx) * 73728;                                                        \
      u16* sQ = (u16*)bb; u16* sK = sQ + 64 * 136; u16* sKT = sK + 64 * 136; u16* sT = sKT + 128 * 72; u16* sAt = sT + 64 * 72; \
      float* sgc = (float*)(bb + 71680); float* sbt = sgc + 64; float* sD = sgc + 128;               \
      XPS1(P, 0) XPS1(P, 1) XPS1(P, 2) XPS1(P, 3)                                                    \
      {                                                                                              \
        const int row = tid >> 3, cc = tid & 7;                                                      \
        *(uint4*)(sT + row * 72 + cc * 8) = P##t0;                                                   \
        *(uint4*)(sT + (row + 32) * 72 + cc * 8) = P##t1;                                            \
        *(uint4*)(sAt + row * 72 + cc * 8) = P##a0;                                                  \
        *(uint4*)(sAt + (row + 32) * 72 + cc * 8) = P##a1;                                           \
      }                                                                                              \
      if (tid < 64) { const float gl = __shfl(P##gc, 63); sgc[tid] = __expf(P##gc); sD[tid] = __expf(gl - P##gc); sbt[tid] = P##bt; } \
    } while (0)
#define XWARM(nn)                                                                                    \
    do {                                                                                             \
      const int vchunk = chunk0 + (d ? nchunk - 1 - (nn) : (nn));                                    \
      _Pragma("unroll") for (int i = 0; i < 4; ++i) {                                                \
        const int ch = tid + 256 * i, row = ch >> 4, kc = ch & 15;                                   \
        const uint4 w = *(const uint4*)(qkv2 + (size_t)(vchunk * 64 + row) * 1536 + 1024 + hd * 128 + kc * 8); \
        fold ^= w.x ^ w.y ^ w.z ^ w.w;                                                               \
      }                                                                                              \
    } while (0)
  if (wid_s >= 4) {
    uint4 Aq0, Aq1, Aq2, Aq3, Ak0, Ak1, Ak2, Ak3, At0, At1, Aa0, Aa1;
    uint4 Bq0, Bq1, Bq2, Bq3, Bk0, Bk1, Bk2, Bk3, Bt0, Bt1, Ba0, Ba1;
    float Agc = 0.f, Abt = 0.f, Bgc = 0.f, Bbt = 0.f;
    unsigned fold = 0u;
    XPF_LOAD(A, 0);
    XPF_LOAD(B, 1);
    XWARM(1);
    XSTORE(A, 0);
    LBAR();
    for (int n = 0; n < nchunk; n += 2) {
      if (n + 2 < nchunk) { XPF_LOAD(A, n + 2); XWARM(n + 2); }
      XSTORE(B, 1);
      LBAR();
      if (n + 3 < nchunk) { XPF_LOAD(B, n + 3); XWARM(n + 3); }
      if (n + 2 < nchunk) XSTORE(A, 0);
      LBAR();
    }
    if (fold == 0x9e3779b9u) *(unsigned*)(smem_all + 72448) = fold;
  } else {
    __builtin_amdgcn_s_setprio(3);
    int wv = tid >> 6, r = tid & 31, h = (tid >> 5) & 1;
    f32x16 S[4];
    {
      const float* s0 = p.state_delta + ((((size_t)seq * 2 + l) * 2 + d) * 4 + hd) * 16384;
#pragma unroll
      for (int kt = 0; kt < 4; ++kt)
#pragma unroll
        for (int i = 0; i < 16; ++i) S[kt][i] = s0[(kt * 32 + crow(i, h)) * 128 + wv * 32 + r];
    }
    f32x16 vv[2];
    VV_LOAD(0);
    LBAR();
    for (int n = 0; n < nchunk; ++n) {
      const int chunk = chunk0 + (d ? nchunk - 1 - n : n);
      const int t0 = chunk * 64;
      char* bb = smem_all + (n & 1) * 73728;
      u16* sQ = (u16*)bb; u16* sK = sQ + 64 * 136; u16* sKT = sK + 64 * 136; u16* sT = sKT + 128 * 72; u16* sAt = sT + 64 * 72;
      float* sgc = (float*)(bb + 71680); float* sbt = sgc + 64; float* sD = sgc + 128;
      tid = RAWTID & 255;
      wv = tid >> 6; r = tid & 31; h = (tid >> 5) & 1;
      f32x16 VN[2];
      bf16x8 Sb[8];
      {
        f32x16 KS[2];
#pragma unroll
        for (int mt = 0; mt < 2; ++mt)
#pragma unroll
          for (int i = 0; i < 16; ++i) KS[mt][i] = 0.f;
        {
          bf16x8 fa[3][2];
#define LDG_(g_) { fa[(g_) % 3][0] = ldA_perm(sK + r * 136 + ((g_) >> 1) * 32, (g_) & 1, h); fa[(g_) % 3][1] = ldA_perm(sK + (32 + r) * 136 + ((g_) >> 1) * 32, (g_) & 1, h); }
          LDG_(0) LDG_(1)
          __builtin_amdgcn_sched_barrier(0);
#pragma unroll
          for (int g = 0; g < 8; ++g) {
            if (g + 2 < 8) LDG_(g + 2)
            Sb[g] = pack_step(S[g >> 1], g & 1);
            KS[0] = MFMA(fa[g % 3][0], Sb[g], KS[0]);
            KS[1] = MFMA(fa[g % 3][1], Sb[g], KS[1]);
            __builtin_amdgcn_sched_barrier(0);
          }
#undef LDG_
        }
        bf16x8 Rb[2][2];
#pragma unroll
        for (int mt = 0; mt < 2; ++mt) {
          f32x16 R;
#pragma unroll
          for (int g = 0; g < 4; ++g) {
            const float4 b4 = *(const float4*)(sbt + mt * 32 + 8 * g + 4 * h);
            const float4 e4 = *(const float4*)(sgc + mt * 32 + 8 * g + 4 * h);
            R[4 * g + 0] = b4.x * (vv[mt][4 * g + 0] - e4.x * KS[mt][4 * g + 0]);
            R[4 * g + 1] = b4.y * (vv[mt][4 * g + 1] - e4.y * KS[mt][4 * g + 1]);
            R[4 * g + 2] = b4.z * (vv[mt][4 * g + 2] - e4.z * KS[mt][4 * g + 2]);
            R[4 * g + 3] = b4.w * (vv[mt][4 * g + 3] - e4.w * KS[mt][4 * g + 3]);
          }
          Rb[mt][0] = pack_step(R, 0); Rb[mt][1] = pack_step(R, 1);
        }
#pragma unroll
        for (int mo = 0; mo < 2; ++mo)
#pragma unroll
          for (int i = 0; i < 16; ++i) VN[mo][i] = 0.f;
#pragma unroll
        for (int mt = 0; mt < 2; ++mt)
#pragma unroll
          for (int s = 0; s < 2; ++s)
#pragma unroll
            for (int mo = 0; mo < 2; ++mo) {
              bf16x8 at = ldA_perm(sT + (mo * 32 + r) * 72 + mt * 32, s, h);
              VN[mo] = MFMA(at, Rb[mt][s], VN[mo]);
            }
      }
      __builtin_amdgcn_sched_barrier(0);
      if (n + 1 < nchunk) VV_LOAD(n + 1);
      __builtin_amdgcn_sched_barrier(0);
      bf16x8 Vb[2][2];
#pragma unroll
      for (int mt = 0; mt < 2; ++mt) { Vb[mt][0] = pack_step(VN[mt], 0); Vb[mt][1] = pack_step(VN[mt], 1); }
      tid = RAWTID & 255;
      wv = tid >> 6; r = tid & 31; h = (tid >> 5) & 1;
      {
        f32x16 O[2];
#pragma unroll
        for (int mo = 0; mo < 2; ++mo)
#pragma unroll
          for (int i = 0; i < 16; ++i) O[mo][i] = 0.f;
        {
          bf16x8 fa[3][2];
#define LDG_(g_) { fa[(g_) % 3][0] = ldA_perm(sQ + r * 136 + ((g_) >> 1) * 32, (g_) & 1, h); fa[(g_) % 3][1] = ldA_perm(sQ + (32 + r) * 136 + ((g_) >> 1) * 32, (g_) & 1, h); }
          LDG_(0) LDG_(1)
          __builtin_amdgcn_sched_barrier(0);
#pragma unroll
          for (int g = 0; g < 8; ++g) {
            if (g + 2 < 8) LDG_(g + 2)
            O[0] = MFMA(Sb[g], fa[g % 3][0], O[0]);
            O[1] = MFMA(Sb[g], fa[g % 3][1], O[1]);
            __builtin_amdgcn_sched_barrier(0);
          }
#undef LDG_
        }
#pragma unroll
        for (int mo = 0; mo < 2; ++mo) {
          const float e = sgc[mo * 32 + r];
#pragma unroll
          for (int i = 0; i < 16; ++i) O[mo][i] *= e;
        }
#pragma unroll
        for (int mt = 0; mt < 2; ++mt)
#pragma unroll
          for (int s = 0; s < 2; ++s)
#pragma unroll
            for (int mo = 0; mo < 2; ++mo) {
              bf16x8 aa = ldA_perm(sAt + (mo * 32 + r) * 72 + mt * 32, s, h);
              O[mo] = MFMA(Vb[mt][s], aa, O[mo]);
            }
#pragma unroll
        for (int mo = 0; mo < 2; ++mo) {
          const int pos = mo * 32 + r;
          const int tok = t0 + (d ? 63 - pos : pos);
          u16* orow = odst + (size_t)tok * 512 + hd * 128 + wv * 32 + 4 * h;
#pragma unroll
          for (int g = 0; g < 4; ++g) {
            uint2 o2;
            o2.x = pack2(O[mo][4 * g + 0], O[mo][4 * g + 1]);
            o2.y = pack2(O[mo][4 * g + 2], O[mo][4 * g + 3]);
            *(uint2*)(orow + 8 * g) = o2;
          }
        }
        __builtin_amdgcn_sched_barrier(0);
      }
      const float eg = sgc[63];
#pragma unroll
      for (int mt = 0; mt < 2; ++mt) {
#pragma unroll
        for (int g = 0; g < 4; ++g) {
          const float4 d4 = *(const float4*)(sD + mt * 32 + 8 * g + 4 * h);
          VN[mt][4 * g + 0] *= d4.x; VN[mt][4 * g + 1] *= d4.y; VN[mt][4 * g + 2] *= d4.z; VN[mt][4 * g + 3] *= d4.w;
        }
        Vb[mt][0] = pack_step(VN[mt], 0); Vb[mt][1] = pack_step(VN[mt], 1);
      }
#pragma unroll
      for (int kt = 0; kt < 4; ++kt)
#pragma unroll
        for (int i = 0; i < 16; ++i) S[kt][i] *= eg;
      {
        bf16x8 fa[3][2];
#define LDK1_(dst_, kt_, mt_, s_) { const u16* krow_ = sKT + ((kt_) * 32 + r) * 72; const int gsw = 4 * (((kt_) * 4 + (r >> 3)) & 15); \
          s16x4 klo = *(const s16x4*)(krow_ + (((mt_) * 32 + 16 * (s_) + 4 * h) ^ gsw)); s16x4 khi = *(const s16x4*)(krow_ + (((mt_) * 32 + 16 * (s_) + 8 + 4 * h) ^ gsw)); \
          dst_ = __builtin_shufflevector(klo, khi, 0, 1, 2, 3, 4, 5, 6, 7); }
#define LDG_(g_) { LDK1_(fa[(g_) % 3][0], 2 * ((g_) & 1), (g_) >> 2, ((g_) >> 1) & 1) LDK1_(fa[(g_) % 3][1], 2 * ((g_) & 1) + 1, (g_) >> 2, ((g_) >> 1) & 1) }
        LDG_(0) LDG_(1)
        __builtin_amdgcn_sched_barrier(0);
#pragma unroll
        for (int g = 0; g < 8; ++g) {
          if (g + 2 < 8) LDG_(g + 2)
          S[2 * (g & 1)] = MFMA(fa[g % 3][0], Vb[g >> 2][(g >> 1) & 1], S[2 * (g & 1)]);
          S[2 * (g & 1) + 1] = MFMA(fa[g % 3][1], Vb[g >> 2][(g >> 1) & 1], S[2 * (g & 1) + 1]);
          __builtin_amdgcn_sched_barrier(0);
        }
#undef LDG_
#undef LDK1_
      }
      LBAR();
    }
    __builtin_amdgcn_s_setprio(0);
  }
#undef PF1
#undef PF_LOAD
#undef VV_LOAD
#undef PS1
#undef XPF1
#undef XPF_LOAD
#undef XPS1
#undef XSTORE
#undef XWARM
#undef LBAR
}

DI void phase_onorm(const Params& p, const int wid_s, int l) {
  const u16* of = (const u16*)(p.ws + OFF_R3);
  const u16* ob = (const u16*)(p.ws + OFF_OB);
  u16* z = (u16*)(p.ws + OFF_R2);
  int tid_ = VTID; asm volatile("" : "+v"(tid_)); const int tid = tid_, lane = tid & 63, wv = tid >> 6;
  float gn[8];
#pragma unroll
  for (int e = 0; e < 8; ++e) gn[e] = p.dn_norm[l * 128 + ((lane * 8 + e) & 127)];
  for (int it = VB; it < 1536; it += VGRID) {
    uint4 la[4], lb[4], lz[4];
#pragma unroll
    for (int rr = 0; rr < 4; ++rr) {
      const size_t off = (size_t)(it * 16 + wv * 4 + rr) * 512 + lane * 8;
      la[rr] = nt_load4u(of + off); lb[rr] = nt_load4u(ob + off); lz[rr] = nt_load4u(z + off);
    }
#pragma unroll
    for (int rr = 0; rr < 4; ++rr) {
      const int t = it * 16 + wv * 4 + rr;
      const size_t off = (size_t)t * 512 + lane * 8;
      const uint4 a = la[rr], b = lb[rr], zz = lz[rr];
      float o[8];
      o[0] = bflo(a.x) + bflo(b.x); o[1] = bfhi(a.x) + bfhi(b.x); o[2] = bflo(a.y) + bflo(b.y); o[3] = bfhi(a.y) + bfhi(b.y);
      o[4] = bflo(a.z) + bflo(b.z); o[5] = bfhi(a.z) + bfhi(b.z); o[6] = bflo(a.w) + bflo(b.w); o[7] = bfhi(a.w) + bfhi(b.w);
      float zf[8] = {bflo(zz.x), bfhi(zz.x), bflo(zz.y), bfhi(zz.y), bflo(zz.z), bfhi(zz.z), bflo(zz.w), bfhi(zz.w)};
      float ss = 0.f;
#pragma unroll
      for (int e = 0; e < 8; ++e) ss += o[e] * o[e];
      ss += __shfl_xor(ss, 1); ss += __shfl_xor(ss, 2); ss += __shfl_xor(ss, 4); ss += __shfl_xor(ss, 8);
      const float rstd = rsqrtf(ss * (1.f / 128.f) + EPSF);
      float y[8];
#pragma unroll
      for (int e = 0; e < 8; ++e) y[e] = o[e] * rstd * gn[e] * siluf(zf[e]);
      uint4 w;
      w.x = pack2(y[0], y[1]); w.y = pack2(y[2], y[3]); w.z = pack2(y[4], y[5]); w.w = pack2(y[6], y[7]);
      *(uint4*)(z + off) = w;
    }
  }
}

DI void phase_final(const Params& p, const int wid_s) {
  const float* adap = (const float*)(p.ws + OFF_ADAP);
  const u16* delta = (const u16*)(p.ws + OFF_R2);
  int tid_ = VTID; asm volatile("" : "+v"(tid_)); const int tid = tid_, lane = tid & 63, wv = tid >> 6;
  float g[16];
#pragma unroll
  for (int q = 0; q < 4; ++q)
#pragma unroll
    for (int e = 0; e < 4; ++e) g[q * 4 + e] = p.final_norm[q * 256 + lane * 4 + e];
  for (int it = VB; it < 1536; it += VGRID) {
    const int ci = cond_idx(it * 16);
    float gt[16];
#pragma unroll
    for (int q = 0; q < 4; ++q)
#pragma unroll
      for (int e = 0; e < 4; ++e) gt[q * 4 + e] = ada_get(adap, 1, ci, 5 * 1024 + q * 256 + lane * 4 + e);
    float4 v[4][4];
    uint2 dl[4][4];
#pragma unroll
    for (int rr = 0; rr < 4; ++rr) {
      const int t = it * 16 + wv * 4 + rr;
#pragma unroll
      for (int q = 0; q < 4; ++q) {
        v[rr][q] = nt_load4f(p.out + (size_t)t * DM + q * 256 + lane * 4);
        dl[rr][q] = nt_load2u(delta + (size_t)t * 1024 + q * 256 + lane * 4);
      }
    }
#pragma unroll
    for (int rr = 0; rr < 4; ++rr) {
      const int t = it * 16 + wv * 4 + rr;
      float* xr = p.out + (size_t)t * DM;
      float ss = 0.f;
#pragma unroll
      for (int q = 0; q < 4; ++q) {
        const uint2 d2 = dl[rr][q];
        v[rr][q].x += gt[q * 4 + 0] * bflo(d2.x); v[rr][q].y += gt[q * 4 + 1] * bfhi(d2.x);
        v[rr][q].z += gt[q * 4 + 2] * bflo(d2.y); v[rr][q].w += gt[q * 4 + 3] * bfhi(d2.y);
        ss += v[rr][q].x * v[rr][q].x + v[rr][q].y * v[rr][q].y + v[rr][q].z * v[rr][q].z + v[rr][q].w * v[rr][q].w;
      }
#pragma unroll
      for (int o = 32; o > 0; o >>= 1) ss += __shfl_xor(ss, o);
      const float rstd = rsqrtf(ss * (1.f / 1024.f) + EPSF);
#pragma unroll
      for (int q = 0; q < 4; ++q) {
        float4 o4;
        o4.x = v[rr][q].x * rstd * g[q * 4 + 0]; o4.y = v[rr][q].y * rstd * g[q * 4 + 1];
        o4.z = v[rr][q].z * rstd * g[q * 4 + 2]; o4.w = v[rr][q].w * rstd * g[q * 4 + 3];
        nt_store4f(xr + q * 256 + lane * 4, o4);
      }
    }
  }
}

constexpr size_t OFF_BAR = 255524864;
constexpr int BAR_WORDS = 64 * 34;
DI unsigned xb_ld(unsigned* q) { return __hip_atomic_load(q, __ATOMIC_RELAXED, __HIP_MEMORY_SCOPE_AGENT); }
DI unsigned xb_add(unsigned* q, unsigned v) { return __hip_atomic_fetch_add(q, v, __ATOMIC_RELAXED, __HIP_MEMORY_SCOPE_AGENT); }
DI void xb_st(unsigned* q, unsigned v) { __hip_atomic_store(q, v, __ATOMIC_RELAXED, __HIP_MEMORY_SCOPE_AGENT); }
DI void fast_barrier(unsigned* bar, unsigned& bk, const int wid_s) {
  asm volatile("s_waitcnt vmcnt(0)" ::: "memory");
  __syncthreads();
  ++bk;
  if (RAWTID == 0) {
    const unsigned G = gridDim.x; unsigned g = blockIdx.x & 15u;
    asm volatile("" : "+s"(g));
    const unsigned gsize = (G - g + 15u) >> 4;
    const unsigned ngroups = G < 16u ? G : 16u;
    __builtin_amdgcn_fence(__ATOMIC_RELEASE, "agent");
    asm volatile("s_waitcnt vmcnt(0)" ::: "memory");
    const unsigned old = xb_add(&bar[64 * g], 1u);
    if (old + 1u == bk * gsize) {
      const unsigned o2 = xb_add(&bar[64 * 32], 1u);
      if (o2 + 1u == bk * ngroups) xb_st(&bar[64 * 33], bk);
      else while (xb_ld(&bar[64 * 33]) < bk) __builtin_amdgcn_s_sleep(1);
      xb_st(&bar[64 * (16 + g)], bk);
    } else {
      while (xb_ld(&bar[64 * (16 + g)]) < bk) __builtin_amdgcn_s_sleep(1);
    }
    __builtin_amdgcn_fence(__ATOMIC_ACQUIRE, "agent");
    asm volatile("s_waitcnt vmcnt(0)" ::: "memory");
  }
  __syncthreads();
}
#define GSYNC() fast_barrier(bar, bk, wid_s)
__global__ void __launch_bounds__(512, 2) fwd_megakernel(Params p) {
  __shared__ __attribute__((aligned(16))) char smem_all[147456];
  cg::grid_group grid = cg::this_grid();
  unsigned* bar = (unsigned*)(p.ws + OFF_BAR);
  unsigned bk = 0;
  const int wid_s = __builtin_amdgcn_readfirstlane(threadIdx.x >> 6);
  if (p.out == nullptr) grid.sync();
#define smem (smem_all + (wid_s >> 2) * 73728)
  phase_ada(p, wid_s, smem);
  phase_wconv(p, wid_s, 0, smem, 0, 704, false, VB, VGRID);
  GSYNC();
#pragma unroll 1
  for (int l = 0; l < 2; ++l) {
    phase_modnorm(p, wid_s, l, 0, l == 0, (u16*)(p.ws + OFF_R1), l == 0 ? nullptr : (const u16*)(p.ws + OFF_R2), l - 1, 5);
    GSYNC();
    gemm8p<EPI_PROJ>(p, wid_s, l, (const u16*)(p.ws + OFF_R1), (const u16*)(p.ws + OFF_R1), 1024, 1024,
                    (const u16*)(p.ws + OFF_WIN), 1024, 1024, 10, 0, false, smem_all);
    ab_sliver(p, wid_s, smem_all);
    GSYNC();
    phase_conv_pool(p, wid_s, l, smem);
    GSYNC();
    phase_intra(p, wid_s, l, smem);
    GSYNC();
    if (blockIdx.x < 64) {
      phase_scan_lat8(p, wid_s, l, smem_all);
    } else {
      phase_scan(p, wid_s, l, smem);
      const int hb = VB - 128, nhb = VGRID - 128;
      phase_wconv(p, wid_s, l, smem, 704, 3072, true, hb, nhb);
      if (l == 0) phase_wconv(p, wid_s, 1, smem, 0, 704, false, hb, nhb);
    }
    GSYNC();
    phase_onorm(p, wid_s, l);
    GSYNC();
    gemm8p<EPI_RESID>(p, wid_s, l, (const u16*)(p.ws + OFF_R2), (const u16*)(p.ws + OFF_R4), 512, 512,
                      (const u16*)(p.ws + OFF_WOUT), 1024, 1024, 4, 2, false, smem_all);
    GSYNC();
    phase_modnorm(p, wid_s, l, 1, l == 0, (u16*)(p.ws + OFF_R2), (const u16*)(p.ws + OFF_R1), l, 2);
    GSYNC();
    gemm8p<EPI_SWIGLU>(p, wid_s, l, (const u16*)(p.ws + OFF_R2), (const u16*)(p.ws + OFF_R2), 1024, 1024,
                      (const u16*)(p.ws + OFF_WGU), 1024, 1024, 22, 0, false, smem_all);
    GSYNC();
    gemm8p<EPI_RESID>(p, wid_s, l, (const u16*)(p.ws + OFF_R0), (const u16*)(p.ws + OFF_R0), DFF, DFF,
                      (const u16*)(p.ws + OFF_WDN), DFF, DFF, 4, 5, false, smem_all);
    GSYNC();
  }
  phase_final(p, wid_s);
}

extern "C" void kernel_launch(void* const* d_in, const int* in_sizes, int n_in, void* d_out, int out_size, void* d_ws,
                              size_t ws_size, hipStream_t stream) {
  static int grid_blocks = 0;
  if (!grid_blocks) {
    int dev = 0, cus = 0, per_cu = 0;
    (void)hipGetDevice(&dev);
    (void)hipDeviceGetAttribute(&cus, hipDeviceAttributeMultiprocessorCount, dev);
    (void)hipOccupancyMaxActiveBlocksPerMultiprocessor(&per_cu, fwd_megakernel, 512, 0);
    if (per_cu > 1) per_cu = 1;
    if (per_cu < 1) per_cu = 1;
    grid_blocks = cus * per_cu;
  }
  Params p{};
  const float** pf = (const float**)&p;
  for (int i = 0; i < 20; ++i) pf[i] = (const float*)d_in[i];
  p.out = (float*)d_out;
  p.ws = (char*)d_ws;
  (void)hipMemsetAsync((char*)d_ws + OFF_BAR, 0, BAR_WORDS * sizeof(unsigned) + (size_t)2 * 9 * 6144 * sizeof(float), stream);
  void* args[] = {&p};
  hipError_t e = hipLaunchCooperativeKernel((void*)fwd_megakernel, dim3(grid_blocks), dim3(512), args, 0, stream);
  if (e != hipSuccess) fprintf(stderr, "cooperative launch failed: %s (grid %d)\n", hipGetErrorString(e), grid_blocks);
}
```

```cpp
#include <hip/hip_runtime.h>
#include <hip/hip_cooperative_groups.h>
#include <cstdio>
namespace cg = cooperative_groups;

typedef __attribute__((ext_vector_type(8))) short bf16x8;
typedef __attribute__((ext_vector_type(4))) short s16x4;
typedef __attribute__((ext_vector_type(16))) float f32x16;
typedef __attribute__((ext_vector_type(2))) __bf16 bf2_t;
typedef __attribute__((ext_vector_type(2))) float f2_t;
typedef unsigned short u16;

#define DI __device__ __forceinline__
#define MFMA(a, b, c) __builtin_amdgcn_mfma_f32_32x32x16_bf16((a), (b), (c), 0, 0, 0)

DI unsigned pack2(float a, float b) { f2_t v = {a, b}; return __builtin_bit_cast(unsigned, __builtin_convertvector(v, bf2_t)); }
DI u16 f2bf(float a) { return (u16)(pack2(a, 0.f) & 0xffffu); }
DI float bf2f(u16 x) { return __uint_as_float(((unsigned)x) << 16); }
DI float bflo(unsigned x) { return __uint_as_float(x << 16); }
DI float bfhi(unsigned x) { return __uint_as_float(x & 0xffff0000u); }
DI int crow(int reg, int h) { return (reg & 3) + 8 * (reg >> 2) + 4 * h; }
typedef float nt_f4 __attribute__((ext_vector_type(4)));
typedef unsigned nt_u2 __attribute__((ext_vector_type(2)));
DI float4 nt_load4f(const float* q) { nt_f4 v = __builtin_nontemporal_load((const nt_f4*)q); return make_float4(v[0], v[1], v[2], v[3]); }
DI void nt_store4f(float* q, float4 v) { nt_f4 w = {v.x, v.y, v.z, v.w}; __builtin_nontemporal_store(w, (nt_f4*)q); }
typedef unsigned nt_u4 __attribute__((ext_vector_type(4)));
DI uint4 nt_load4u(const u16* q) { nt_u4 v = __builtin_nontemporal_load((const nt_u4*)q); return make_uint4(v[0], v[1], v[2], v[3]); }
DI uint2 nt_load2u(const u16* q) { nt_u2 v = __builtin_nontemporal_load((const nt_u2*)q); return make_uint2(v[0], v[1]); }
DI float siluf(float x) { return x * __builtin_amdgcn_rcpf(1.f + __expf(-x)); }

constexpr int NT = 24576;
constexpr int NCTX = 8192;
constexpr int DM = 1024;
constexpr int DFF = 2816;
constexpr int INC = 2576;
constexpr int INP = 2816;
constexpr float EPSF = 1e-6f;
DI int raw_tid_f(const int wid_s) {
  unsigned m = ~0u;
  asm volatile("" : "+s"(m));
  int t = wid_s * 64 + (int)__builtin_amdgcn_mbcnt_hi(m, __builtin_amdgcn_mbcnt_lo(m, 0u));
  asm volatile("" : "+v"(t));
  return t;
}
#define RAWTID raw_tid_f(wid_s)
#define raw_tid() RAWTID
#define VB ((int)(blockIdx.x * 2 + (raw_tid() >> 8)))
#define VGRID ((int)(gridDim.x * 2))
#define VTID ((int)(raw_tid() & 255))

constexpr size_t OFF_R0 = 0;
constexpr size_t OFF_R1 = 75497472;
constexpr size_t OFF_R2 = 150994944;
constexpr size_t OFF_R3 = 176160768;
constexpr size_t OFF_R4 = 201326592;
constexpr size_t OFF_WIN = 256114688;
constexpr size_t OFF_WOUT = 231997440;
constexpr size_t OFF_WGU = 234094592;
constexpr size_t OFF_WDN = 245628928;
constexpr size_t OFF_GB = 251396096;
constexpr size_t OFF_ADAP = 255533568;
constexpr size_t OFF_GC = 254738432;
constexpr size_t OFF_T = OFF_R0;
constexpr size_t OFF_ATT = OFF_R0 + 25165824;
constexpr size_t OFF_OB = OFF_R0 + 50331648;
constexpr int ADAP_STRIDE = 2 * 9 * 6144;
constexpr size_t OFF_GATE = 255533568;


struct Params {
  const float *x_prompt, *x_sample, *c, *state_delta, *c_ctx, *w_ada, *b_ada, *norm_mix, *norm_ffn, *w_in, *conv_w,
      *a_log, *dt_bias, *dn_norm, *pool_w, *pool_scale, *w_out, *w_gu, *w_down, *final_norm;
  float* out;
  char* ws;
};

DI float ada_get(const float* adap, int l, int ci, int j) {
  return adap[((size_t)l * 9 + ci) * 6144 + j];
}
DI int cond_idx(int t) { return t < NCTX ? 0 : 1 + ((t - NCTX) >> 11); }
DI const float* xrow(const Params& p, bool from_input, int t) {
  if (from_input) return t < NCTX ? p.x_prompt + (size_t)t * DM : p.x_sample + (size_t)(t - NCTX) * DM;
  return p.out + (size_t)t * DM;
}

DI void phase_ada(const Params& p, const int wid_s, char* smem) {
  float* s_silu = (float*)smem;
  float* s_red = s_silu + 9 * 256;
  float* adap = (float*)(p.ws + OFF_ADAP);
  int tid_ = VTID; asm volatile("" : "+v"(tid_)); const int tid = tid_, lane = tid & 63, wv = tid >> 6;
  for (int it = VB; it < 768; it += VGRID) {
    const int kq = it & 3, ct = (it >> 2) % 96, l = it / 384;
    __syncthreads();
    for (int e = tid; e < 9 * 256; e += 256) {
      int ci = e >> 8, k = kq * 256 + (e & 255);
      float cv = (ci == 0) ? p.c_ctx[k] : p.c[(ci - 1) * 1024 + k];
      s_silu[e] = siluf(cv);
    }
    __syncthreads();
    float acc[9];
#pragma unroll
    for (int ci = 0; ci < 9; ++ci) acc[ci] = 0.f;
    const float* w = p.w_ada + ((size_t)l * 1024 + kq * 256 + wv * 64) * 6144 + ct * 64 + lane;
#pragma unroll 8
    for (int k = 0; k < 64; ++k) {
      float wvv = __builtin_nontemporal_load(&w[(size_t)k * 6144]);
#pragma unroll
      for (int ci = 0; ci < 9; ++ci) acc[ci] += s_silu[ci * 256 + wv * 64 + k] * wvv;
    }
#pragma unroll
    for (int ci = 0; ci < 9; ++ci) s_red[(wv * 9 + ci) * 64 + lane] = acc[ci];
    __syncthreads();
    for (int e = tid; e < 9 * 64; e += 256) {
      int ci = e >> 6, cl = e & 63;
      float v = s_red[(0 * 9 + ci) * 64 + cl] + s_red[(1 * 9 + ci) * 64 + cl] + s_red[(2 * 9 + ci) * 64 + cl] +
                s_red[(3 * 9 + ci) * 64 + cl];
      int col = ct * 64 + cl;
      if (kq == 0) v += p.b_ada[l * 6144 + col];
      atomicAdd(&adap[((size_t)l * 9 + ci) * 6144 + col], v);
    }
  }
}

DI void phase_wconv(const Params& p, const int wid_s, int l, char* smem, int lo, int hi, bool do_fold, int hb, int nhb) {
  float* tile = (float*)smem;
  int tid_ = VTID; asm volatile("" : "+v"(tid_)); const int tid = tid_;
  for (int it0 = lo + hb; it0 < hi; it0 += nhb) {
    int it = it0;
    const float* src; int ld, ldd, n0, k0, mode; u16* dst;
    if (it < 704) { mode = 0; n0 = (it / 16) * 64; k0 = (it % 16) * 64; src = p.w_in + (size_t)l * 1024 * INC; ld = INC; dst = (u16*)(p.ws + OFF_WIN); ldd = 1024; }
    else if (it < 2112) { it -= 704; mode = 1; n0 = (it / 16) * 64; k0 = (it % 16) * 64; src = p.w_gu + (size_t)l * 1024 * 5632; ld = 5632; dst = (u16*)(p.ws + OFF_WGU); ldd = 1024; }
    else if (it < 2816) { it -= 2112; mode = 2; n0 = (it / 44) * 64; k0 = (it % 44) * 64; src = p.w_down + (size_t)l * DFF * 1024; ld = 1024; dst = (u16*)(p.ws + OFF_WDN); ldd = DFF; }
    else { it -= 2816; mode = 3; n0 = (it / 16) * 64; k0 = (it % 16) * 64; src = p.w_out + (size_t)l * 1024 * 1024; ld = 1024; dst = (u16*)(p.ws + OFF_WOUT); ldd = 1024; }
    if (mode == 3 && k0 >= 512) continue;
    __syncthreads();
    {
      const int n4 = tid & 15;
      const int np = n0 + n4 * 4;
      int col = np; bool valid = true;
      if (mode == 0) {
        if (np < 2048) col = np; else if (np < 2560) col = np + 16; else if (np < 2576) col = np - 512; else { valid = false; col = 0; }
      } else if (mode == 1) {
        int tl = np >> 8, bj = (np >> 7) & 1, wc = (np >> 5) & 3, half = (np >> 4) & 1, j = np & 15;
        col = half * DFF + tl * 128 + bj * 64 + wc * 16 + j;
      }
#pragma unroll
      for (int i = 0; i < 4; ++i) {
        const int kk = (tid >> 4) + 16 * i;
        float4 v = {0.f, 0.f, 0.f, 0.f};
        if (valid) v = nt_load4f(src + (size_t)(k0 + kk) * ld + col);
        *(float4*)(tile + kk * 68 + n4 * 4) = v;
      }
    }
    __syncthreads();
    {
      const int n = tid & 63;
#pragma unroll
      for (int i = 0; i < 2; ++i) {
        const int k8 = (tid >> 6) + 4 * i;
        float e[8];
#pragma unroll
        for (int q = 0; q < 8; ++q) e[q] = tile[(k8 * 8 + q) * 68 + n];
        uint4 o;
        o.x = pack2(e[0], e[1]); o.y = pack2(e[2], e[3]); o.z = pack2(e[4], e[5]); o.w = pack2(e[6], e[7]);
        *(uint4*)(dst + (size_t)(n0 + n) * ldd + k0 + k8 * 8) = o;
      }
    }
  }
  if (do_fold) {
    u16* dst = (u16*)(p.ws + OFF_WOUT);
    const float* wo = p.w_out + (size_t)l * 1024 * 1024;
    float* pwl = (float*)smem;
    float* psl = pwl + 16 * 128;
    for (int it = hb; it < 128; it += nhb) {
      const int ntile = it & 3, ib = (it >> 2) & 7, g = it >> 5;
      const int n = ntile * 256 + tid;
      const float* pw = p.pool_w + (((size_t)l * 4 + g) * 128 + ib * 16) * 128;
      const float* ps = p.pool_scale + l * 512 + g * 128;
      __syncthreads();
#pragma unroll
      for (int i = 0; i < 8; ++i) pwl[tid + 256 * i] = pw[tid + 256 * i];
      if (tid < 128) psl[tid] = ps[tid];
      __syncthreads();
      const float* wsrc = wo + (size_t)(512 + 128 * g) * 1024 + n;
      float acc[16];
#pragma unroll
      for (int i = 0; i < 16; ++i) acc[i] = 0.f;
#pragma unroll 2
      for (int j = 0; j < 128; j += 4) {
        const float4 s4 = *(const float4*)(psl + j);
        const float w0 = wsrc[(size_t)(j + 0) * 1024] * s4.x, w1 = wsrc[(size_t)(j + 1) * 1024] * s4.y;
        const float w2 = wsrc[(size_t)(j + 2) * 1024] * s4.z, w3 = wsrc[(size_t)(j + 3) * 1024] * s4.w;
#pragma unroll
        for (int i = 0; i < 16; ++i) {
          const float4 c = *(const float4*)(pwl + i * 128 + j);
          acc[i] += c.x * w0 + c.y * w1 + c.z * w2 + c.w * w3;
        }
      }
      uint4 o0, o1;
      o0.x = pack2(acc[0], acc[1]); o0.y = pack2(acc[2], acc[3]); o0.z = pack2(acc[4], acc[5]); o0.w = pack2(acc[6], acc[7]);
      o1.x = pack2(acc[8], acc[9]); o1.y = pack2(acc[10], acc[11]); o1.z = pack2(acc[12], acc[13]); o1.w = pack2(acc[14], acc[15]);
      u16* op = dst + (size_t)n * 1024 + 512 + 128 * g + ib * 16;
      *(uint4*)(op) = o0;
      *(uint4*)(op + 8) = o1;
    }
  }
}

DI void phase_modnorm(const Params& p, const int wid_s, int l, int which, bool from_input, u16* hbuf, const u16* delta, int gl, int gchunk) {
  const float* adap = (const float*)(p.ws + OFF_ADAP);
  const float* gain = (which ? p.norm_ffn : p.norm_mix) + l * 1024;
  int tid_ = VTID; asm volatile("" : "+v"(tid_)); const int tid = tid_, lane = tid & 63, wv = tid >> 6;
  for (int it = VB; it < 1536; it += VGRID) {
    const int tb = it * 16, ci = cond_idx(tb);
    float sc[16], sh[16], gt[16];
#pragma unroll
    for (int q = 0; q < 4; ++q)
#pragma unroll
      for (int e = 0; e < 4; ++e) {
        int c = q * 256 + lane * 4 + e;
        sc[q * 4 + e] = gain[c] * (1.f + ada_get(adap, l, ci, (which ? 4 : 1) * 1024 + c));
        sh[q * 4 + e] = ada_get(adap, l, ci, (which ? 3 : 0) * 1024 + c);
        gt[q * 4 + e] = delta ? ada_get(adap, gl, ci, gchunk * 1024 + c) : 0.f;
      }
    float4 v[4][4];
    uint2 dl[4][4];
#pragma unroll
    for (int rr = 0; rr < 4; ++rr) {
      const int t = tb + wv * 4 + rr;
      const float* xr = xrow(p, from_input, t);
#pragma unroll
      for (int q = 0; q < 4; ++q) {
        v[rr][q] = nt_load4f(xr + q * 256 + lane * 4);
        if (delta) dl[rr][q] = nt_load2u(delta + (size_t)t * 1024 + q * 256 + lane * 4);
      }
    }
#pragma unroll
    for (int rr = 0; rr < 4; ++rr) {
      const int t = tb + wv * 4 + rr;
      float ss = 0.f;
#pragma unroll
      for (int q = 0; q < 4; ++q) {
        if (delta) {
          const uint2 d2 = dl[rr][q];
          v[rr][q].x += gt[q * 4 + 0] * bflo(d2.x); v[rr][q].y += gt[q * 4 + 1] * bfhi(d2.x);
          v[rr][q].z += gt[q * 4 + 2] * bflo(d2.y); v[rr][q].w += gt[q * 4 + 3] * bfhi(d2.y);
          nt_store4f(p.out + (size_t)t * DM + q * 256 + lane * 4, v[rr][q]);
        }
        ss += v[rr][q].x * v[rr][q].x + v[rr][q].y * v[rr][q].y + v[rr][q].z * v[rr][q].z + v[rr][q].w * v[rr][q].w;
      }
#pragma unroll
      for (int o = 32; o > 0; o >>= 1) ss += __shfl_xor(ss, o);
      const float rstd = rsqrtf(ss * (1.f / 1024.f) + EPSF);
#pragma unroll
      for (int q = 0; q < 4; ++q) {
        uint2 o2;
        o2.x = pack2(v[rr][q].x * rstd * sc[q * 4 + 0] + sh[q * 4 + 0], v[rr][q].y * rstd * sc[q * 4 + 1] + sh[q * 4 + 1]);
        o2.y = pack2(v[rr][q].z * rstd * sc[q * 4 + 2] + sh[q * 4 + 2], v[rr][q].w * rstd * sc[q * 4 + 3] + sh[q * 4 + 3]);
        *(uint2*)(hbuf + (size_t)t * 1024 + q * 256 + lane * 4) = o2;
      }
    }
  }
}

enum { EPI_PROJ = 0, EPI_RESID = 1, EPI_SWIGLU = 2 };
typedef __attribute__((ext_vector_type(4))) float f32x4;

DI int lds_byte(int r, int c) {
  int st = (r >> 4) * 2 + (c >> 5), rr = r & 15, cc = c & 31, ob = rr * 64 + cc * 2;
  return st * 1024 + (ob ^ (((ob >> 9) & 1) << 5));
}
DI void stage_rc(int b, int& R, int& C) {
  int st = b / 1024, sb = b % 1024, swz = sb ^ (((sb >> 9) & 1) << 5);
  R = (st >> 1) * 16 + swz / 64;
  C = (st & 1) * 32 + (swz % 64) / 2;
}

template <int EPI>
DI void gemm8p(const Params& p, const int wid_s, int l, const u16* A0, const u16* A1, int ksplit, int lda, const u16* Bt, int ldb,
              int K, int nN, int gate_chunk, bool x_from_input, char* smem) {
  constexpr int BM = 256, BK = 64, HALF = 128, HT = HALF * BK, NXCD = 8, WGM = 8;
  u16* shm = (u16*)smem;
#define SA(b, h) (shm + ((b) * 2 + (h)) * HT)
#define SB(b, h) (shm + (4 + (b) * 2 + (h)) * HT)
#define STAGE_(P, BASE, LD, OFF, br, kcol)                                                            \
  do {                                                                                                \
    _Pragma("unroll") for (int _i = 0; _i < 2; ++_i) {                                                \
      __builtin_amdgcn_global_load_lds((const unsigned*)((BASE) + ((size_t)((br) + 64 * _i) * (LD) + (kcol)) + (OFF)), \
                                       (__attribute__((address_space(3))) unsigned*)((char*)(P) + lds_dst + _i * 8192), 16, 0, 0); \
    }                                                                                                 \
  } while (0)
#define STAGE_A(P, br, kt) do { const int _k0 = (kt) * BK; const bool _lo = _k0 < ksplit; const u16* _ab = _lo ? A0 : A1; const int _kc = _lo ? _k0 : _k0 - ksplit; STAGE_(P, _ab, lda, offA, br, _kc); } while (0)
#define STAGE_B(P, br, kt) STAGE_(P, Bt, ldb, offB, br, (kt) * BK)
#define LDA(dst, b, h) _Pragma("unroll") for (int m = 0; m < 4; ++m) _Pragma("unroll") for (int k = 0; k < 2; ++k) \
    dst[m][k] = *reinterpret_cast<const bf16x8*>((char*)SA(b, h) + a_lane + (m * 2 + k) * 1024)
#define LDB(dst, b, h) _Pragma("unroll") for (int n = 0; n < 2; ++n) _Pragma("unroll") for (int k = 0; k < 2; ++k) \
    dst[n][k] = *reinterpret_cast<const bf16x8*>((char*)SB(b, h) + b_lane + (n * 2 + k) * 1024)
#define MMA(ai, bj, At_, Bt_) do { __builtin_amdgcn_s_setprio(1);                                     \
    _Pragma("unroll") for (int m = 0; m < 4; ++m) _Pragma("unroll") for (int n = 0; n < 2; ++n) _Pragma("unroll") for (int k = 0; k < 2; ++k) \
      acc[ai][bj][m][n] = __builtin_amdgcn_mfma_f32_16x16x32_bf16(Bt_[n][k], At_[m][k], acc[ai][bj][m][n], 0, 0, 0); \
    __builtin_amdgcn_s_setprio(0); } while (0)
#define WAIT_V(n) asm volatile("s_waitcnt vmcnt(" #n ")" ::: "memory")
#define WAIT_L(n) asm volatile("s_waitcnt lgkmcnt(" #n ")" ::: "memory")
#define BAR __builtin_amdgcn_s_barrier()
#define SCHED __builtin_amdgcn_sched_barrier(0)
  const int nM = NT / BM, nwg = nM * nN;
  const int wid = RAWTID >> 6, lane = RAWTID & 63, wr = wid >> 2, wc = wid & 3, fr = lane & 15, fq = lane >> 4;
  const int nt = K / BK;
  const float* adap = (const float*)(p.ws + OFF_ADAP);
  const int lane_off = (fr * 64 + fq * 16) ^ ((fr >> 3) << 5);
  const int a_lane = wr * 8192 + lane_off, b_lane = wc * 4096 + lane_off;
  const int lds_dst = __builtin_amdgcn_readfirstlane(RAWTID >> 6) * 1024;
  int offA0, offB0;
  { const int sb_ = lane * 16, swz_ = sb_ ^ (((sb_ >> 9) & 1) << 5);
    const int sr0 = (wid >> 1) * 16 + swz_ / 64, sc0 = (wid & 1) * 32 + (swz_ % 64) / 2;
    offA0 = sr0 * lda + sc0; offB0 = sr0 * ldb + sc0; }
  auto tile_coords = [&](int L_, int& brow_, int& bcol_, int& pn_) {
    int wgid = L_;
    { const int q = nwg / NXCD, rr = nwg % NXCD, xcd = wgid % NXCD, off = wgid / NXCD;
      wgid = (xcd < rr ? xcd * (q + 1) : rr * (q + 1) + (xcd - rr) * q) + off; }
    const int nig = WGM * nN, gid = wgid / nig, fm = gid * WGM, gsz = (nM - fm) < WGM ? (nM - fm) : WGM;
    const int pm_ = fm + ((wgid % nig) % gsz);
    pn_ = (wgid % nig) / gsz; brow_ = pm_ * BM; bcol_ = pn_ * BM;
  };
  int L = blockIdx.x;
  if (L >= nwg) return;
  int brow, bcol, pn;
  tile_coords(L, brow, bcol, pn);
  __syncthreads();
  {
    int offA = offA0, offB = offB0;
    asm volatile("" : "+v"(offA), "+v"(offB));
    STAGE_B(SB(0, 0), bcol, 0); STAGE_A(SA(0, 0), brow, 0);
    STAGE_B(SB(0, 1), bcol + HALF, 0); STAGE_A(SA(0, 1), brow + HALF, 0);
  }
  for (;;) {
    int offA = offA0, offB = offB0;
    asm volatile("" : "+v"(offA), "+v"(offB));
    f32x4 acc[2][2][4][2];
#pragma unroll
    for (int a = 0; a < 2; ++a)
#pragma unroll
      for (int b = 0; b < 2; ++b)
#pragma unroll
        for (int m = 0; m < 4; ++m)
#pragma unroll
          for (int n = 0; n < 2; ++n) acc[a][b][m][n] = (f32x4){0.f, 0.f, 0.f, 0.f};
    bf16x8 At[4][2], B0[2][2], B1[2][2];
    if (wr == 1) BAR;
    WAIT_V(4); BAR;
    STAGE_B(SB(1, 0), bcol, 1); STAGE_A(SA(1, 0), brow, 1); STAGE_B(SB(1, 1), bcol + HALF, 1);
    WAIT_V(6); BAR;
    for (int t = 0; t < nt - 2; t += 2) {
      LDB(B0, 0, 0); SCHED; LDA(At, 0, 0); STAGE_A(SA(1, 1), brow + HALF, t + 1);
      WAIT_L(8); BAR; WAIT_L(0); MMA(0, 0, At, B0); BAR; SCHED;
      LDB(B1, 0, 1); STAGE_B(SB(0, 0), bcol, t + 2);
      BAR; WAIT_L(0); MMA(0, 1, At, B1); BAR;
      LDA(At, 0, 1); STAGE_A(SA(0, 0), brow, t + 2);
      BAR; WAIT_L(0); MMA(1, 0, At, B0); BAR; SCHED;
      STAGE_B(SB(0, 1), bcol + HALF, t + 2);
      WAIT_V(6); BAR; MMA(1, 1, At, B1); BAR;
      LDB(B0, 1, 0); SCHED; LDA(At, 1, 0); STAGE_A(SA(0, 1), brow + HALF, t + 2);
      WAIT_L(8); BAR; WAIT_L(0); MMA(0, 0, At, B0); BAR; SCHED;
      LDB(B1, 1, 1); STAGE_B(SB(1, 0), bcol, t + 3);
      BAR; WAIT_L(0); MMA(0, 1, At, B1); BAR;
      LDA(At, 1, 1); STAGE_A(SA(1, 0), brow, t + 3);
      BAR; WAIT_L(0); MMA(1, 0, At, B0); BAR; SCHED;
      STAGE_B(SB(1, 1), bcol + HALF, t + 3);
      WAIT_V(6); BAR; MMA(1, 1, At, B1); BAR;
    }
    { LDB(B0, 0, 0); LDA(At, 0, 0); STAGE_A(SA(1, 1), brow + HALF, nt - 1);
      BAR; WAIT_L(0); MMA(0, 0, At, B0); BAR;
      LDB(B1, 0, 1); BAR; WAIT_L(0); MMA(0, 1, At, B1); BAR;
      LDA(At, 0, 1); WAIT_V(4); BAR; WAIT_L(0); MMA(1, 0, At, B0); MMA(1, 1, At, B1); BAR; }
    { LDB(B0, 1, 0); LDA(At, 1, 0); WAIT_V(2); BAR; WAIT_L(0); MMA(0, 0, At, B0); BAR;
      LDB(B1, 1, 1); WAIT_V(0); BAR; WAIT_L(0); MMA(0, 1, At, B1); BAR;
      LDA(At, 1, 1); BAR; WAIT_L(0); MMA(1, 0, At, B0); MMA(1, 1, At, B1); BAR; }
    if (wr == 0) BAR;
    const int Ln = L + gridDim.x;
    const bool more = Ln < nwg;
    int browN = 0, bcolN = 0, pnN = 0;
    if (more) {
      tile_coords(Ln, browN, bcolN, pnN);
      STAGE_B(SB(0, 0), bcolN, 0); STAGE_A(SA(0, 0), browN, 0);
      STAGE_B(SB(0, 1), bcolN + HALF, 0); STAGE_A(SA(0, 1), browN + HALF, 0);
    }
    __builtin_amdgcn_sched_barrier(0);
    int tid_e = RAWTID;
    asm volatile("" : "+v"(tid_e));
    const int wr_e = tid_e >> 8, wc_e = (tid_e >> 6) & 3, fr_e = tid_e & 15, fq_e = (tid_e >> 4) & 3;
    if constexpr (EPI == EPI_PROJ) {
      const size_t poff = pn < 6 ? OFF_R0 : (pn < 8 ? OFF_R2 : OFF_R3);
      const int ldo = pn < 6 ? 1536 : 512;
      const int cbase = pn < 6 ? bcol : (pn < 8 ? bcol - 1536 : bcol - 2048);
      u16* dst = (u16*)(p.ws + poff) + (size_t)brow * ldo + cbase;
      const int loff = (wr_e * 64 + fr_e) * ldo + wc_e * 32 + fq_e * 4;
#pragma unroll
      for (int ai = 0; ai < 2; ++ai)
#pragma unroll
        for (int m = 0; m < 4; ++m) {
          u16* rowp = dst + (ai * HALF + m * 16) * ldo + loff;
#pragma unroll
          for (int bj = 0; bj < 2; ++bj)
#pragma unroll
            for (int n = 0; n < 2; ++n) {
              const f32x4 v = acc[ai][bj][m][n];
              uint2 o; o.x = pack2(v[0], v[1]); o.y = pack2(v[2], v[3]);
              *(uint2*)(rowp + bj * HALF + n * 16) = o;
            }
        }
    } else if constexpr (EPI == EPI_RESID) {
      u16* dst = (u16*)(p.ws + (gate_chunk == 2 ? OFF_R1 : OFF_R2)) + (size_t)brow * 1024 + bcol;
      const int loff = (wr_e * 64 + fr_e) * 1024 + wc_e * 32 + fq_e * 4;
#pragma unroll
      for (int ai = 0; ai < 2; ++ai)
#pragma unroll
        for (int m = 0; m < 4; ++m) {
          u16* rowp = dst + (ai * HALF + m * 16) * 1024 + loff;
#pragma unroll
          for (int bj = 0; bj < 2; ++bj)
#pragma unroll
            for (int n = 0; n < 2; ++n) {
              const f32x4 v = acc[ai][bj][m][n];
              uint2 o; o.x = pack2(v[0], v[1]); o.y = pack2(v[2], v[3]);
              *(uint2*)(rowp + bj * HALF + n * 16) = o;
            }
        }
    } else {
      u16* act = (u16*)(p.ws + OFF_R0);
#pragma unroll
      for (int ai = 0; ai < 2; ++ai)
#pragma unroll
        for (int m = 0; m < 4; ++m) {
          u16* rowp = act + (size_t)(brow + ai * HALF + wr_e * 64 + m * 16 + fr_e) * DFF + pn * 128 + wc_e * 16 + fq_e * 4;
#pragma unroll
          for (int bj = 0; bj < 2; ++bj) {
            const f32x4 g = acc[ai][bj][m][0], u = acc[ai][bj][m][1];
            uint2 o;
            o.x = pack2(siluf(g[0]) * u[0], siluf(g[1]) * u[1]);
            o.y = pack2(siluf(g[2]) * u[2], siluf(g[3]) * u[3]);
            *(uint2*)(rowp + bj * 64) = o;
          }
        }
    }
    if (!more) break;
    L = Ln; brow = browN; bcol = bcolN; pn = pnN;
  }
#undef SA
#undef SB
#undef STAGE_
#undef STAGE_A
#undef STAGE_B
#undef LDA
#undef LDB
#undef MMA
#undef WAIT_V
#undef WAIT_L
#undef BAR
#undef SCHED
}

DI void ab_sliver(const Params& p, const int wid_s, char* smem_all) {
  const u16* hbuf = (const u16*)(p.ws + OFF_R1);
  const u16* wab = (const u16*)(p.ws + OFF_WIN) + (size_t)2560 * 1024;
  float* gb = (float*)(p.ws + OFF_GB);
  const int tid = RAWTID, wv = tid >> 6, lane = tid & 63, r = lane & 31, h = lane >> 5;
  const int hb_ = (gridDim.x == 256) ? (int)blockIdx.x - 192 : (int)gridDim.x - 1 - (int)blockIdx.x;
  const int nhb_ = (gridDim.x == 256) ? 64 : (int)gridDim.x;
  if (hb_ < 0 || hb_ * 8 >= 768) return;
  u16* sW = (u16*)smem_all;
  __syncthreads();
#pragma unroll
  for (int i = 0; i < 8; ++i) {
    const int ch = tid + 512 * i, row = ch >> 7, kc = ch & 127;
    *(uint4*)(sW + row * 1032 + kc * 8) = *(const uint4*)(wab + (size_t)row * 1024 + kc * 8);
  }
  __syncthreads();
  for (int wj = hb_ * 8 + wv; wj < 768; wj += nhb_ * 8) {
    const int row0 = wj * 32;
    f32x16 acc;
#pragma unroll
    for (int i = 0; i < 16; ++i) acc[i] = 0.f;
    u16* sAw = (u16*)(smem_all + 67584) + wv * 2304;
    const int lrow = lane >> 3, lkc = lane & 7;
    const u16* ag = hbuf + (size_t)(row0 + lrow) * 1024 + lkc * 8;
    const u16* bp = sW + r * 1032 + h * 8;
    uint4 c0 = *(const uint4*)(ag), c1 = *(const uint4*)(ag + 8 * 1024), c2 = *(const uint4*)(ag + 16 * 1024), c3 = *(const uint4*)(ag + 24 * 1024);
    for (int c = 0; c < 16; ++c) {
      *(uint4*)(sAw + lrow * 72 + lkc * 8) = c0;
      *(uint4*)(sAw + (lrow + 8) * 72 + lkc * 8) = c1;
      *(uint4*)(sAw + (lrow + 16) * 72 + lkc * 8) = c2;
      *(uint4*)(sAw + (lrow + 24) * 72 + lkc * 8) = c3;
      if (c + 1 < 16) {
        const u16* an = ag + (c + 1) * 64;
        c0 = *(const uint4*)(an); c1 = *(const uint4*)(an + 8 * 1024); c2 = *(const uint4*)(an + 16 * 1024); c3 = *(const uint4*)(an + 24 * 1024);
      }
#pragma unroll
      for (int s = 0; s < 4; ++s) {
        bf16x8 a = *(const bf16x8*)(sAw + r * 72 + s * 16 + h * 8);
        bf16x8 b = *(const bf16x8*)(bp + c * 64 + s * 16);
        acc = MFMA(b, a, acc);
      }
    }
    float* rowp = gb + (size_t)(row0 + r) * 16 + 4 * h;
    float4 o0 = {acc[0], acc[1], acc[2], acc[3]};
    float4 o1 = {acc[4], acc[5], acc[6], acc[7]};
    *(float4*)(rowp) = o0;
    *(float4*)(rowp + 8) = o1;
  }
}

DI void phase_conv_pool(const Params& p, const int wid_s, int l, char* smem) {
  const u16* raw = (const u16*)(p.ws + OFF_R0);
  u16* qkv2 = (u16*)(p.ws + OFF_R1);
  const u16* pool = (const u16*)(p.ws + OFF_R3);
  u16* pm = (u16*)(p.ws + OFF_R4);
  float* s1 = (float*)smem;
  int tid_ = VTID; asm volatile("" : "+v"(tid_)); const int tid = tid_, lane = tid & 63, wv = tid >> 6;
  for (int it = VB; it < 1152 + 1024 + 512; it += VGRID) {
    if (it < 1152) {
      const int chunk = it / 3, sec = it % 3;
      const int t0 = chunk * 64;
      int seq_lo, seq_hi;
      if (t0 < NCTX) { seq_lo = t0 & ~255; seq_hi = seq_lo + 256; } else { seq_lo = NCTX + ((t0 - NCTX) & ~2047); seq_hi = seq_lo + 2048; }
      const int cb = sec * 512 + lane * 8;
      float w[5][8];
#pragma unroll
      for (int j = 0; j < 5; ++j)
#pragma unroll
        for (int e = 0; e < 8; ++e) w[j][e] = p.conv_w[((size_t)l * 5 + j) * 1536 + cb + e];
      uint4 rwa[20];
#pragma unroll
      for (int j = 0; j < 20; ++j) {
        int ts = t0 + wv * 16 + j - 2;
        rwa[j] = (ts >= seq_lo && ts < seq_hi) ? *(const uint4*)(raw + (size_t)ts * 1536 + cb) : make_uint4(0u, 0u, 0u, 0u);
      }
#pragma unroll
      for (int tq = 0; tq < 16; tq += 4) {
        const int tb = t0 + wv * 16 + tq;
        const uint4* rw = rwa + tq;
#pragma unroll
        for (int u = 0; u < 4; ++u) {
          float a[8];
#pragma unroll
          for (int e = 0; e < 8; ++e) a[e] = 0.f;
#pragma unroll
          for (int j = 0; j < 5; ++j) {
            const uint4 v = rw[u + j];
            a[0] += w[j][0] * bflo(v.x); a[1] += w[j][1] * bfhi(v.x);
            a[2] += w[j][2] * bflo(v.y); a[3] += w[j][3] * bfhi(v.y);
            a[4] += w[j][4] * bflo(v.z); a[5] += w[j][5] * bfhi(v.z);
            a[6] += w[j][6] * bflo(v.w); a[7] += w[j][7] * bfhi(v.w);
          }
          float ss = 0.f;
#pragma unroll
          for (int e = 0; e < 8; ++e) { a[e] = siluf(a[e]); ss += a[e] * a[e]; }
          float scl = 1.f;
          if (sec < 2) {
            ss += __shfl_xor(ss, 1); ss += __shfl_xor(ss, 2); ss += __shfl_xor(ss, 4); ss += __shfl_xor(ss, 8);
            scl = rsqrtf(ss + EPSF);
            if (sec == 0) scl *= 0.08838834764831845f;
          }
          uint4 o;
          o.x = pack2(a[0] * scl, a[1] * scl); o.y = pack2(a[2] * scl, a[3] * scl);
          o.z = pack2(a[4] * scl, a[5] * scl); o.w = pack2(a[6] * scl, a[7] * scl);
          *(uint4*)(qkv2 + (size_t)(tb + u) * 1536 + cb) = o;
        }
      }
    } else if (it < 1152 + 1024) {
      const int j = it - 1152;
      const int gi = (j < 512) ? (j & 3) : 3 - (j & 3), rr = (j >> 2) & 31, b = j >> 7;
      const int win = 2 << gi;
      int rlo = rr - win / 2; if (rlo < 0) rlo = 0;
      int rhi = rr - win / 2 + win; if (rhi > 32) rhi = 32;
      const int tbase = NCTX + b * 2048;
      __syncthreads();
      {
        float a[4][8];
#pragma unroll
        for (int i = 0; i < 4; ++i)
#pragma unroll
          for (int e = 0; e < 8; ++e) a[i][e] = 0.f;
        for (int r2 = rlo; r2 < rhi; r2 += 4) {
          uint4 x[4][4];
#pragma unroll
          for (int k = 0; k < 4; ++k)
#pragma unroll
            for (int i = 0; i < 4; ++i) {
              const int v = tid + 256 * i, col = v >> 4, cv = v & 15;
              x[k][i] = (r2 + k < rhi) ? *(const uint4*)(pool + (size_t)(tbase + (r2 + k) * 64 + col) * 512 + gi * 128 + cv * 8)
                                       : make_uint4(0u, 0u, 0u, 0u);
            }
#pragma unroll
          for (int k = 0; k < 4; ++k)
#pragma unroll
            for (int i = 0; i < 4; ++i) {
              a[i][0] += bflo(x[k][i].x); a[i][1] += bfhi(x[k][i].x); a[i][2] += bflo(x[k][i].y); a[i][3] += bfhi(x[k][i].y);
              a[i][4] += bflo(x[k][i].z); a[i][5] += bfhi(x[k][i].z); a[i][6] += bflo(x[k][i].w); a[i][7] += bfhi(x[k][i].w);
            }
        }
#pragma unroll
        for (int i = 0; i < 4; ++i) {
          const int v = tid + 256 * i, col = v >> 4, cv = v & 15;
          *(float4*)(s1 + col * 128 + cv * 8) = make_float4(a[i][0], a[i][1], a[i][2], a[i][3]);
          *(float4*)(s1 + col * 128 + cv * 8 + 4) = make_float4(a[i][4], a[i][5], a[i][6], a[i][7]);
        }
      }
      __syncthreads();
#pragma unroll
      for (int i = 0; i < 4; ++i) {
        int v = tid + 256 * i, col = v >> 4, cv = v & 15;
        int clo = col - win / 2; if (clo < 0) clo = 0;
        int chi = col - win / 2 + win; if (chi > 64) chi = 64;
        float a[8];
#pragma unroll
        for (int e = 0; e < 8; ++e) a[e] = 0.f;
        for (int c2 = clo; c2 < chi; c2 += 4) {
          float4 x0[4], x1[4];
#pragma unroll
          for (int k = 0; k < 4; ++k) {
            const int cc = (c2 + k < chi) ? c2 + k : clo;
            x0[k] = *(const float4*)(s1 + cc * 128 + cv * 8);
            x1[k] = *(const float4*)(s1 + cc * 128 + cv * 8 + 4);
          }
#pragma unroll
          for (int k = 0; k < 4; ++k) {
            const float m = (c2 + k < chi) ? 1.f : 0.f;
            a[0] += m * x0[k].x; a[1] += m * x0[k].y; a[2] += m * x0[k].z; a[3] += m * x0[k].w;
            a[4] += m * x1[k].x; a[5] += m * x1[k].y; a[6] += m * x1[k].z; a[7] += m * x1[k].w;
          }
        }
        const float inv = __builtin_amdgcn_rcpf((float)((rhi - rlo) * (chi - clo)));
        const size_t off = (size_t)(tbase + rr * 64 + col) * 512 + gi * 128 + cv * 8;
        uint4 u = *(const uint4*)(pool + off);
        uint4 o;
        o.x = pack2(a[0] * inv - bflo(u.x), a[1] * inv - bfhi(u.x));
        o.y = pack2(a[2] * inv - bflo(u.y), a[3] * inv - bfhi(u.y));
        o.z = pack2(a[4] * inv - bflo(u.z), a[5] * inv - bfhi(u.z));
        o.w = pack2(a[6] * inv - bflo(u.w), a[7] * inv - bfhi(u.w));
        *(uint4*)(pm + off) = o;
      }
    } else {
      const int j = it - 1152 - 1024;
      const int gi = j & 3, chunk = j >> 2;
      const int win = 2 << gi;
      const int seqbase = (chunk >> 2) * 256, pos0 = (chunk & 3) * 64;
#pragma unroll
      for (int i = 0; i < 4; ++i) {
        int v = tid + 256 * i, col = v >> 4, cv = v & 15;
        int pos = pos0 + col;
        int lo = pos - win / 2; if (lo < 0) lo = 0;
        int hi = pos - win / 2 + win; if (hi > 256) hi = 256;
        float a[8];
#pragma unroll
        for (int e = 0; e < 8; ++e) a[e] = 0.f;
        for (int p2 = lo; p2 < hi; p2 += 8) {
          uint4 x[8];
#pragma unroll
          for (int k = 0; k < 8; ++k)
            x[k] = (p2 + k < hi) ? *(const uint4*)(pool + (size_t)(seqbase + p2 + k) * 512 + gi * 128 + cv * 8) : make_uint4(0u, 0u, 0u, 0u);
#pragma unroll
          for (int k = 0; k < 8; ++k) {
            a[0] += bflo(x[k].x); a[1] += bfhi(x[k].x); a[2] += bflo(x[k].y); a[3] += bfhi(x[k].y);
            a[4] += bflo(x[k].z); a[5] += bfhi(x[k].z); a[6] += bflo(x[k].w); a[7] += bfhi(x[k].w);
          }
        }
        const float inv = __builtin_amdgcn_rcpf((float)(hi - lo));
        const size_t off = (size_t)(seqbase + pos) * 512 + gi * 128 + cv * 8;
        uint4 u = *(const uint4*)(pool + off);
        uint4 o;
        o.x = pack2(a[0] * inv - bflo(u.x), a[1] * inv - bfhi(u.x));
        o.y = pack2(a[2] * inv - bflo(u.y), a[3] * inv - bfhi(u.y));
        o.z = pack2(a[4] * inv - bflo(u.z), a[5] * inv - bfhi(u.z));
        o.w = pack2(a[6] * inv - bflo(u.w), a[7] * inv - bfhi(u.w));
        *(uint4*)(pm + off) = o;
      }
    }
  }
}

DI void phase_intra(const Params& p, const int wid_s, int l, char* smem) {
  u16* sQ = (u16*)smem;
  u16* sK = sQ + 64 * 136;
  float* sL = (float*)smem;
  float* sGkk = (float*)(smem + 34816);
  float* sGqk = sGkk + 64 * 65;
  float* sgc = (float*)(smem + 68096);
  float* sbt = sgc + 128;
  const u16* qkv2 = (const u16*)(p.ws + OFF_R1);
  const float* gb = (const float*)(p.ws + OFF_GB);
  u16* Tout = (u16*)(p.ws + OFF_T);
  u16* Aout = (u16*)(p.ws + OFF_ATT);
  float* gcbuf = (float*)(p.ws + OFF_GC);
  int tid_ = VTID; asm volatile("" : "+v"(tid_)); const int tid = tid_, lane = tid & 63, wv = tid >> 6, r = lane & 31, h = lane >> 5;
  for (int it = VB; it < 1536; it += VGRID) {
    const int chunk = it >> 2, hd = it & 3;
    const int t0 = chunk * 64;
    __syncthreads();
#pragma unroll
    for (int i = 0; i < 4; ++i) {
      int ch = tid + 256 * i, row = ch >> 4, kc = ch & 15;
      uint4 vq = *(const uint4*)(qkv2 + (size_t)(t0 + row) * 1536 + hd * 128 + kc * 8);
      uint4 vk = *(const uint4*)(qkv2 + (size_t)(t0 + row) * 1536 + 512 + hd * 128 + kc * 8);
      *(uint4*)(sQ + row * 136 + kc * 8) = vq;
      *(uint4*)(sK + row * 136 + kc * 8) = vk;
    }
    if (tid < 128) {
      int d = tid >> 6, i = tid & 63;
      int tok = t0 + (d ? 63 - i : i);
      sbt[tid] = __builtin_amdgcn_rcpf(1.f + __expf(-gb[(size_t)tok * 16 + d * 4 + hd]));
      const float xx = gb[(size_t)tok * 16 + 8 + d * 4 + hd] + p.dt_bias[(l * 2 + d) * 4 + hd];
      const float sp = (xx > 20.f) ? xx : log1pf(__expf(xx));
      sgc[tid] = -__expf(p.a_log[(l * 2 + d) * 4 + hd]) * sp;
    }
    __syncthreads();
    if (tid < 128) {
      float a = sgc[tid];
#pragma unroll
      for (int o = 1; o < 64; o <<= 1) { const float t = __shfl_up(a, o); if (lane >= o) a += t; }
      sgc[tid] = a;
    }
    {
      const int mt = wv >> 1, nt = wv & 1;
      f32x16 akk, aqk;
#pragma unroll
      for (int i = 0; i < 16; ++i) { akk[i] = 0.f; aqk[i] = 0.f; }
#pragma unroll
      for (int s = 0; s < 8; ++s) {
        bf16x8 bk = *(const bf16x8*)(sK + (nt * 32 + r) * 136 + s * 16 + h * 8);
        bf16x8 ak = *(const bf16x8*)(sK + (mt * 32 + r) * 136 + s * 16 + h * 8);
        bf16x8 aq = *(const bf16x8*)(sQ + (mt * 32 + r) * 136 + s * 16 + h * 8);
        akk = MFMA(ak, bk, akk);
        aqk = MFMA(aq, bk, aqk);
      }
#pragma unroll
      for (int i = 0; i < 16; ++i) {
        int row = mt * 32 + crow(i, h), col = nt * 32 + r;
        sGkk[row * 65 + col] = akk[i];
        sGqk[row * 65 + col] = aqk[i];
      }
    }
    __syncthreads();
    for (int e = tid; e < 2 * 64 * 64; e += 256) {
      int d = e >> 12, i = (e >> 6) & 63, j = e & 63;
      int ti = d ? 63 - i : i, tj = d ? 63 - j : j;
      float dec = (i >= j) ? __expf(sgc[d * 64 + i] - sgc[d * 64 + j]) : 0.f;
      float Lv = (i > j) ? sbt[d * 64 + i] * sGkk[ti * 65 + tj] * dec : 0.f;
      sL[e] = Lv;
      Aout[((size_t)it * 2 + d) * 4096 + i * 64 + j] = f2bf(sGqk[ti * 65 + tj] * dec);
    }
    if (tid < 128) gcbuf[((size_t)it * 2 + (tid >> 6)) * 64 + (tid & 63)] = sgc[tid];
    __syncthreads();
    if (wv < 2) {
      const int d = wv;
      const float* L = sL + d * 4096;
      float x[64];
#pragma unroll
      for (int i = 0; i < 64; ++i) x[i] = 0.f;
#pragma unroll
      for (int i = 0; i < 64; ++i) {
        float a0 = (lane == i) ? 1.f : 0.f, a1 = 0.f, a2 = 0.f, a3 = 0.f;
#pragma unroll
        for (int j4 = 0; j4 < (i + 3) / 4; ++j4) {
          const float4 lv = *(const float4*)(L + i * 64 + j4 * 4);
          a0 -= lv.x * x[j4 * 4 + 0]; a1 -= lv.y * x[j4 * 4 + 1]; a2 -= lv.z * x[j4 * 4 + 2]; a3 -= lv.w * x[j4 * 4 + 3];
        }
        x[i] = (a0 + a1) + (a2 + a3);
      }
      u16* To = Tout + ((size_t)it * 2 + d) * 4096;
#pragma unroll
      for (int i = 0; i < 64; ++i) To[i * 64 + lane] = f2bf(x[i]);
    }
  }
}

DI bf16x8 ldA_perm(const u16* rowp, int s, int h) {
  s16x4 lo = *(const s16x4*)(rowp + 16 * s + 4 * h);
  s16x4 hi = *(const s16x4*)(rowp + 16 * s + 8 + 4 * h);
  return __builtin_shufflevector(lo, hi, 0, 1, 2, 3, 4, 5, 6, 7);
}
DI bf16x8 pack_step(const f32x16& x, int s) {
  unsigned a = pack2(x[8 * s + 0], x[8 * s + 1]), b = pack2(x[8 * s + 2], x[8 * s + 3]);
  unsigned c = pack2(x[8 * s + 4], x[8 * s + 5]), d = pack2(x[8 * s + 6], x[8 * s + 7]);
  uint4 u = {a, b, c, d};
  return __builtin_bit_cast(bf16x8, u);
}

DI void phase_scan(const Params& p, const int wid_s, int l, char* smem) {
  u16* sQ = (u16*)smem;
  u16* sK = sQ + 64 * 136;
  u16* sKT = sK + 64 * 136;
  u16* sT = sKT + 128 * 72;
  u16* sAt = sT + 64 * 72;
  float* sgc = (float*)(smem + 71680);
  float* sbt = sgc + 64;
  float* sD = sgc + 128;
  const u16* qkv2 = (const u16*)(p.ws + OFF_R1);
  const float* gb = (const float*)(p.ws + OFF_GB);
  const u16* Tbuf = (const u16*)(p.ws + OFF_T);
  const u16* Abuf = (const u16*)(p.ws + OFF_ATT);
  const float* gcbuf = (const float*)(p.ws + OFF_GC);
  u16* of = (u16*)(p.ws + OFF_R3);
  u16* ob = (u16*)(p.ws + OFF_OB);
  const int tid0 = VTID;
  for (int it = 64 + (VB - 128); it < 320; it += VGRID) {
    int tid = tid0;
    asm volatile("" : "+v"(tid));
    int wv = tid >> 6, r = tid & 31, h = (tid >> 5) & 1;
    int seq, hd, d, nchunk, chunk0; bool is_lat;
    if (it < 64) { is_lat = true; seq = it >> 3; hd = (it >> 1) & 3; d = it & 1; nchunk = 32; chunk0 = 128 + seq * 32; }
    else { int j = it - 64; is_lat = false; seq = j >> 3; hd = (j >> 1) & 3; d = j & 1; nchunk = 4; chunk0 = seq * 4; }
    u16* odst = d ? ob : of;
    f32x16 S[4];
    if (is_lat) {
      const float* s0 = p.state_delta + ((((size_t)seq * 2 + l) * 2 + d) * 4 + hd) * 16384;
#pragma unroll
      for (int kt = 0; kt < 4; ++kt)
#pragma unroll
        for (int i = 0; i < 16; ++i) S[kt][i] = s0[(kt * 32 + crow(i, h)) * 128 + wv * 32 + r];
    } else {
#pragma unroll
      for (int kt = 0; kt < 4; ++kt)
#pragma unroll
        for (int i = 0; i < 16; ++i) S[kt][i] = 0.f;
    }
    uint4 pq0, pq1, pq2, pq3, pk0, pk1, pk2, pk3, pt0, pt1, pa0, pa1;
    float pgc = 0.f, pbt = 0.f;
    f32x16 vv[2];
#define PF1(i)                                                                                       \
    {                                                                                                \
      const int ch = tid + 256 * i, row = ch >> 4, kc = ch & 15;                                     \
      const int tok = pt0_ + (d ? 63 - row : row);                                                   \
      pq##i = *(const uint4*)(qkv2 + (size_t)tok * 1536 + hd * 128 + kc * 8);                        \
      pk##i = *(const uint4*)(qkv2 + (size_t)tok * 1536 + 512 + hd * 128 + kc * 8);                  \
    }
#define PF_LOAD(nn)                                                                                  \
    do {                                                                                             \
      const int pchunk = chunk0 + (d ? nchunk - 1 - (nn) : (nn));                                    \
      const int pt0_ = pchunk * 64;                                                                  \
      const size_t pcix = ((size_t)pchunk * 4 + hd) * 2 + d;                                         \
      PF1(0) PF1(1) PF1(2) PF1(3)                                                                    \
      {                                                                                              \
        const int row = tid >> 3, cc = tid & 7;                                                      \
        pt0 = *(const uint4*)(Tbuf + pcix * 4096 + row * 64 + cc * 8);                               \
        pt1 = *(const uint4*)(Tbuf + pcix * 4096 + (row + 32) * 64 + cc * 8);                        \
        pa0 = *(const uint4*)(Abuf + pcix * 4096 + row * 64 + cc * 8);                               \
        pa1 = *(const uint4*)(Abuf + pcix * 4096 + (row + 32) * 64 + cc * 8);                        \
      }                                                                                              \
      if (tid < 64) {                                                                                \
        pgc = gcbuf[pcix * 64 + tid];                                                                \
        pbt = __builtin_amdgcn_rcpf(1.f + __expf(-gb[(size_t)(pt0_ + (d ? 63 - tid : tid)) * 16 + d * 4 + hd]));    \
      }                                                                                              \
    } while (0)
#define VV_LOAD(nn)                                                                                  \
    do {                                                                                             \
      const int vchunk = chunk0 + (d ? nchunk - 1 - (nn) : (nn));                                    \
      const int vt0 = vchunk * 64;                                                                   \
      _Pragma("unroll") for (int mt = 0; mt < 2; ++mt)                                               \
      _Pragma("unroll") for (int i = 0; i < 16; ++i) {                                               \
        const int pos = mt * 32 + crow(i, h);                                                        \
        const int tok = vt0 + (d ? 63 - pos : pos);                                                  \
        vv[mt][i] = bf2f(qkv2[(size_t)tok * 1536 + 1024 + hd * 128 + wv * 32 + r]);                  \
      }                                                                                              \
    } while (0)
#define PS1(i)                                                                                       \
    {                                                                                                \
      const int ch = tid + 256 * i, row = ch >> 4, kc = ch & 15;                                     \
      *(uint4*)(sQ + row * 136 + kc * 8) = pq##i;                                                    \
      *(uint4*)(sK + row * 136 + kc * 8) = pk##i;                                                    \
      u16* kt_ = sKT + (kc * 8) * 72 + (row ^ (4 * kc));      \
      kt_[0 * 72] = (u16)(pk##i.x & 0xffff); kt_[1 * 72] = (u16)(pk##i.x >> 16);                     \
      kt_[2 * 72] = (u16)(pk##i.y & 0xffff); kt_[3 * 72] = (u16)(pk##i.y >> 16);                     \
      kt_[4 * 72] = (u16)(pk##i.z & 0xffff); kt_[5 * 72] = (u16)(pk##i.z >> 16);                     \
      kt_[6 * 72] = (u16)(pk##i.w & 0xffff); kt_[7 * 72] = (u16)(pk##i.w >> 16);                     \
    }
    for (int n = 0; n < nchunk; ++n) {
      const int chunk = chunk0 + (d ? nchunk - 1 - n : n);
      const int t0 = chunk * 64;
      __syncthreads();
      asm volatile("" : "+v"(tid));
      wv = tid >> 6; r = tid & 31; h = (tid >> 5) & 1;
      PF_LOAD(n);
      VV_LOAD(n);
      PS1(0) PS1(1) PS1(2) PS1(3)
      {
        const int row = tid >> 3, cc = tid & 7;
        *(uint4*)(sT + row * 72 + cc * 8) = pt0;
        *(uint4*)(sT + (row + 32) * 72 + cc * 8) = pt1;
        *(uint4*)(sAt + row * 72 + cc * 8) = pa0;
        *(uint4*)(sAt + (row + 32) * 72 + cc * 8) = pa1;
      }
      if (tid < 64) { const float gl = __shfl(pgc, 63); sgc[tid] = __expf(pgc); sD[tid] = __expf(gl - pgc); sbt[tid] = pbt; }
      __syncthreads();
      f32x16 VN[2];
      {
        f32x16 KS[2];
#pragma unroll
        for (int mt = 0; mt < 2; ++mt)
#pragma unroll
          for (int i = 0; i < 16; ++i) KS[mt][i] = 0.f;
#pragma unroll
        for (int kt = 0; kt < 4; ++kt)
#pragma unroll
          for (int s = 0; s < 2; ++s) {
            const bf16x8 sb = pack_step(S[kt], s);
#pragma unroll
            for (int mt = 0; mt < 2; ++mt) {
              bf16x8 ak = ldA_perm(sK + (mt * 32 + r) * 136 + kt * 32, s, h);
              KS[mt] = MFMA(ak, sb, KS[mt]);
            }
            __builtin_amdgcn_sched_barrier(0);
          }
        bf16x8 Rb[2][2];
#pragma unroll
        for (int mt = 0; mt < 2; ++mt) {
          f32x16 R;
#pragma unroll
          for (int i = 0; i < 16; ++i) {
            int pos = mt * 32 + crow(i, h);
            R[i] = sbt[pos] * (vv[mt][i] - sgc[pos] * KS[mt][i]);
          }
          Rb[mt][0] = pack_step(R, 0); Rb[mt][1] = pack_step(R, 1);
        }
#pragma unroll
        for (int mo = 0; mo < 2; ++mo) {
#pragma unroll
          for (int i = 0; i < 16; ++i) VN[mo][i] = 0.f;
#pragma unroll
          for (int mt = 0; mt < 2; ++mt)
#pragma unroll
            for (int s = 0; s < 2; ++s) {
              bf16x8 at = ldA_perm(sT + (mo * 32 + r) * 72 + mt * 32, s, h);
              VN[mo] = MFMA(at, Rb[mt][s], VN[mo]);
            }
        }
      }
      __builtin_amdgcn_sched_barrier(0);
      bf16x8 Vb[2][2];
#pragma unroll
      for (int mt = 0; mt < 2; ++mt) { Vb[mt][0] = pack_step(VN[mt], 0); Vb[mt][1] = pack_step(VN[mt], 1); }
      asm volatile("" : "+v"(tid));
      wv = tid >> 6; r = tid & 31; h = (tid >> 5) & 1;
#pragma unroll
      for (int mo = 0; mo < 2; ++mo) {
        f32x16 O;
#pragma unroll
        for (int i = 0; i < 16; ++i) O[i] = 0.f;
#pragma unroll
        for (int kt = 0; kt < 4; ++kt)
#pragma unroll
          for (int s = 0; s < 2; ++s) {
            const bf16x8 sb = pack_step(S[kt], s);
            bf16x8 aq = ldA_perm(sQ + (mo * 32 + r) * 136 + kt * 32, s, h);
            O = MFMA(aq, sb, O);
          }
#pragma unroll
        for (int i = 0; i < 16; ++i) { int pos = mo * 32 + crow(i, h); O[i] *= sgc[pos]; }
#pragma unroll
        for (int mt = 0; mt < 2; ++mt)
#pragma unroll
          for (int s = 0; s < 2; ++s) {
            bf16x8 aa = ldA_perm(sAt + (mo * 32 + r) * 72 + mt * 32, s, h);
            O = MFMA(aa, Vb[mt][s], O);
          }
#pragma unroll
        for (int i = 0; i < 16; ++i) {
          int pos = mo * 32 + crow(i, h);
          int tok = t0 + (d ? 63 - pos : pos);
          odst[(size_t)tok * 512 + hd * 128 + wv * 32 + r] = f2bf(O[i]);
        }
        __builtin_amdgcn_sched_barrier(0);
      }
      const float eg = sgc[63];
#pragma unroll
      for (int mt = 0; mt < 2; ++mt) {
#pragma unroll
        for (int i = 0; i < 16; ++i) { int pos = mt * 32 + crow(i, h); VN[mt][i] *= sD[pos]; }
        Vb[mt][0] = pack_step(VN[mt], 0); Vb[mt][1] = pack_step(VN[mt], 1);
      }
#pragma unroll
      for (int kt = 0; kt < 4; ++kt) {
#pragma unroll
        for (int i = 0; i < 16; ++i) S[kt][i] *= eg;
#pragma unroll
        for (int mt = 0; mt < 2; ++mt)
#pragma unroll
          for (int s = 0; s < 2; ++s) {
            const u16* krow_ = sKT + (kt * 32 + r) * 72;
            const int gsw = 4 * ((kt * 4 + (r >> 3)) & 15);
            s16x4 klo = *(const s16x4*)(krow_ + ((mt * 32 + 16 * s + 4 * h) ^ gsw));
            s16x4 khi = *(const s16x4*)(krow_ + ((mt * 32 + 16 * s + 8 + 4 * h) ^ gsw));
            bf16x8 ak = __builtin_shufflevector(klo, khi, 0, 1, 2, 3, 4, 5, 6, 7);
            S[kt] = MFMA(ak, Vb[mt][s], S[kt]);
          }
        __builtin_amdgcn_sched_barrier(0);
      }
    }
#undef PF1
#undef PF_LOAD
#undef VV_LOAD
#undef PS1
    if (!is_lat) {
      float* so = p.out + (size_t)NT * DM + ((((size_t)seq * 2 + l) * 2 + d) * 4 + hd) * 16384;
#pragma unroll
      for (int kt = 0; kt < 4; ++kt)
#pragma unroll
        for (int i = 0; i < 16; ++i) __builtin_nontemporal_store(S[kt][i], &so[(kt * 32 + crow(i, h)) * 128 + wv * 32 + r]);
    }
  }
}

DI void phase_scan_lat8(const Params& p, const int wid_s, int l, char* smem_all) {
  const u16* qkv2 = (const u16*)(p.ws + OFF_R1);
  const float* gb = (const float*)(p.ws + OFF_GB);
  const u16* Tbuf = (const u16*)(p.ws + OFF_T);
  const u16* Abuf = (const u16*)(p.ws + OFF_ATT);
  const float* gcbuf = (const float*)(p.ws + OFF_GC);
  u16* of = (u16*)(p.ws + OFF_R3);
  u16* ob = (u16*)(p.ws + OFF_OB);
  const int it = blockIdx.x;
  if (it >= 64) return;
  const int seq = it >> 3, hd = (it >> 1) & 3, d = it & 1, nchunk = 32, chunk0 = 128 + seq * 32;
  u16* odst = d ? ob : of;
  int tid = RAWTID & 255;
#define PF1(i)                                                                                       \
    {                                                                                                \
      const int ch = tid + 256 * i, row = ch >> 4, kc = ch & 15;                                     \
      const int tok = pt0_ + (d ? 63 - row : row);                                                   \
      pq##i = *(const uint4*)(qkv2 + (size_t)tok * 1536 + hd * 128 + kc * 8);                        \
      pk##i = *(const uint4*)(qkv2 + (size_t)tok * 1536 + 512 + hd * 128 + kc * 8);                  \
    }
#define PF_LOAD(nn)                                                                                  \
    do {                                                                                             \
      const int pchunk = chunk0 + (d ? nchunk - 1 - (nn) : (nn));                                    \
      const int pt0_ = pchunk * 64;                                                                  \
      const size_t pcix = ((size_t)pchunk * 4 + hd) * 2 + d;                                         \
      PF1(0) PF1(1) PF1(2) PF1(3)                                                                    \
      {                                                                                              \
        const int row = tid >> 3, cc = tid & 7;                                                      \
        pt0 = *(const uint4*)(Tbuf + pcix * 4096 + row * 64 + cc * 8);                               \
        pt1 = *(const uint4*)(Tbuf + pcix * 4096 + (row + 32) * 64 + cc * 8);                        \
        pa0 = *(const uint4*)(Abuf + pcix * 4096 + row * 64 + cc * 8);                               \
        pa1 = *(const uint4*)(Abuf + pcix * 4096 + (row + 32) * 64 + cc * 8);                        \
      }                                                                                              \
      if (tid < 64) {                                                                                \
        pgc = gcbuf[pcix * 64 + tid];                                                                \
        pbt = __builtin_amdgcn_rcpf(1.f + __expf(-gb[(size_t)(pt0_ + (d ? 63 - tid : tid)) * 16 + d * 4 + hd]));    \
      }                                                                                              \
    } while (0)
#define VV_LOAD(nn)                                                                                  \
    do {                                                                                             \
      const int vchunk = chunk0 + (d ? nchunk - 1 - (nn) : (nn));                                    \
      const int vt0 = vchunk * 64;                                                                   \
      _Pragma("unroll") for (int mt = 0; mt < 2; ++mt)                                               \
      _Pragma("unroll") for (int i = 0; i < 16; ++i) {                                               \
        const int pos = mt * 32 + crow(i, h);                                                        \
        const int tok = vt0 + (d ? 63 - pos : pos);                                                  \
        vv[mt][i] = bf2f(qkv2[(size_t)tok * 1536 + 1024 + hd * 128 + wv * 32 + r]);                  \
      }                                                                                              \
    } while (0)
#define PS1(i)                                                                                       \
    {                                                                                                \
      const int ch = tid + 256 * i, row = ch >> 4, kc = ch & 15;                                     \
      *(uint4*)(sQ + row * 136 + kc * 8) = pq##i;                                                    \
      *(uint4*)(sK + row * 136 + kc * 8) = pk##i;                                                    \
      u16* kt_ = sKT + (kc * 8) * 72 + (row ^ (4 * kc));      \
      kt_[0 * 72] = (u16)(pk##i.x & 0xffff); kt_[1 * 72] = (u16)(pk##i.x >> 16);                     \
      kt_[2 * 72] = (u16)(pk##i.y & 0xffff); kt_[3 * 72] = (u16)(pk##i.y >> 16);                     \
      kt_[4 * 72] = (u16)(pk##i.z & 0xffff); kt_[5 * 72] = (u16)(pk##i.z >> 16);                     \
      kt_[6 * 72] = (u16)(pk##i.w & 0xffff); kt_[7 * 72] = (u16)(pk##i.w >> 16);                     \
    }

#define XPF1(P, i)                                                                                   \
    {                                                                                                \
      const int ch = tid + 256 * i, row = ch >> 4, kc = ch & 15;                                     \
      const int tok = pt0_ + (d ? 63 - row : row);                                                   \
      P##q##i = *(const uint4*)(qkv2 + (size_t)tok * 1536 + hd * 128 + kc * 8);                      \
      P##k##i = *(const uint4*)(qkv2 + (size_t)tok * 1536 + 512 + hd * 128 + kc * 8);                \
    }
#define XPF_LOAD(P, nn)                                                                              \
    do {                                                                                             \
      const int pchunk = chunk0 + (d ? nchunk - 1 - (nn) : (nn));                                    \
      const int pt0_ = pchunk * 64;                                                                  \
      const size_t pcix = ((size_t)pchunk * 4 + hd) * 2 + d;                                         \
      XPF1(P, 0) XPF1(P, 1) XPF1(P, 2) XPF1(P, 3)                                                    \
      {                                                                                              \
        const int row = tid >> 3, cc = tid & 7;                                                      \
        P##t0 = *(const uint4*)(Tbuf + pcix * 4096 + row * 64 + cc * 8);                             \
        P##t1 = *(const uint4*)(Tbuf + pcix * 4096 + (row + 32) * 64 + cc * 8);                      \
        P##a0 = *(const uint4*)(Abuf + pcix * 4096 + row * 64 + cc * 8);                             \
        P##a1 = *(const uint4*)(Abuf + pcix * 4096 + (row + 32) * 64 + cc * 8);                      \
      }                                                                                              \
      if (tid < 64) {                                                                                \
        P##gc = gcbuf[pcix * 64 + tid];                                                              \
        P##bt = __builtin_amdgcn_rcpf(1.f + __expf(-gb[(size_t)(pt0_ + (d ? 63 - tid : tid)) * 16 + d * 4 + hd]));  \
      }                                                                                              \
    } while (0)
#define XPS1(P, i)                                                                                   \
    {                                                                                                \
      const int ch = tid + 256 * i, row = ch >> 4, kc = ch & 15;                                     \
      *(uint4*)(sQ + row * 136 + kc * 8) = P##q##i;                                                  \
      *(uint4*)(sK + row * 136 + kc * 8) = P##k##i;                                                  \
      u16* kt_ = sKT + (kc * 8) * 72 + (row ^ (4 * kc));                                             \
      kt_[0 * 72] = (u16)(P##k##i.x & 0xffff); kt_[1 * 72] = (u16)(P##k##i.x >> 16);                 \
      kt_[2 * 72] = (u16)(P##k##i.y & 0xffff); kt_[3 * 72] = (u16)(P##k##i.y >> 16);                 \
      kt_[4 * 72] = (u16)(P##k##i.z & 0xffff); kt_[5 * 72] = (u16)(P##k##i.z >> 16);                 \
      kt_[6 * 72] = (u16)(P##k##i.w & 0xffff); kt_[7 * 72] = (u16)(P##k##i.w >> 16);                 \
    }
#define XSTORE(P, bufidx)                                                                            \
    do {                                                                                             \
      char* bb = smem_all + (bufidx) * 73728;                                                        \
      u16* sQ = (u16*)bb; u16* sK = sQ + 64 * 136; u16* sKT = sK + 64 * 136; u16* sT = sKT + 128 * 72; u16* sAt = sT + 64 * 72; \
      float* sgc = (float*)(bb + 71680); float* sbt = sgc + 64; float* sD = sgc + 128;               \
      XPS1(P, 0) XPS1(P, 1) XPS1(P, 2) XPS1(P, 3)                                                    \
      {                                                                                              \
        const int row = tid >> 3, cc = tid & 7;                                                      \
        *(uint4*)(sT + row * 72 + cc * 8) = P##t0;                                                   \
        *(uint4*)(sT + (row + 32) * 72 + cc * 8) = P##t1;                                            \
        *(uint4*)(sAt + row * 72 + cc * 8) = P##a0;                                                  \
        *(uint4*)(sAt + (row + 32) * 72 + cc * 8) = P##a1;                                           \
      }                                                                                              \
      if (tid < 64) { const float gl = __shfl(P##gc, 63); sgc[tid] = __expf(P##gc); sD[tid] = __expf(gl - P##gc); sbt[tid] = P##bt; } \
    } while (0)
#define XWARM(nn)                                                                                    \
    do {                                                                                             \
      const int vchunk = chunk0 + (d ? nchunk - 1 - (nn) : (nn));                                    \
      _Pragma("unroll") for (int i = 0; i < 4; ++i) {                                                \
        const int ch = tid + 256 * i, row = ch >> 4, kc = ch & 15;                                   \
        const uint4 w = *(const uint4*)(qkv2 + (size_t)(vchunk * 64 + row) * 1536 + 1024 + hd * 128 + kc * 8); \
        fold ^= w.x ^ w.y ^ w.z ^ w.w;                                                               \
      }                                                                                              \
    } while (0)
  if (wid_s >= 4) {
    uint4 Aq0, Aq1, Aq2, Aq3, Ak0, Ak1, Ak2, Ak3, At0, At1, Aa0, Aa1;
    uint4 Bq0, Bq1, Bq2, Bq3, Bk0, Bk1, Bk2, Bk3, Bt0, Bt1, Ba0, Ba1;
    float Agc = 0.f, Abt = 0.f, Bgc = 0.f, Bbt = 0.f;
    unsigned fold = 0u;
    XPF_LOAD(A, 0);
    XPF_LOAD(B, 1);
    XWARM(1);
    XSTORE(A, 0);
    __syncthreads();
    for (int n = 0; n < nchunk; n += 2) {
      if (n + 2 < nchunk) { XPF_LOAD(A, n + 2); XWARM(n + 2); }
      XSTORE(B, 1);
      __syncthreads();
      if (n + 3 < nchunk) { XPF_LOAD(B, n + 3); XWARM(n + 3); }
      if (n + 2 < nchunk) XSTORE(A, 0);
      __syncthreads();
    }
    if (fold == 0x9e3779b9u) *(unsigned*)(smem_all + 72448) = fold;
  } else {
    __builtin_amdgcn_s_setprio(3);
    int wv = tid >> 6, r = tid & 31, h = (tid >> 5) & 1;
    f32x16 S[4];
    {
      const float* s0 = p.state_delta + ((((size_t)seq * 2 + l) * 2 + d) * 4 + hd) * 16384;
#pragma unroll
      for (int kt = 0; kt < 4; ++kt)
#pragma unroll
        for (int i = 0; i < 16; ++i) S[kt][i] = s0[(kt * 32 + crow(i, h)) * 128 + wv * 32 + r];
    }
    f32x16 vv[2];
    VV_LOAD(0);
    __syncthreads();
    for (int n = 0; n < nchunk; ++n) {
      const int chunk = chunk0 + (d ? nchunk - 1 - n : n);
      const int t0 = chunk * 64;
      char* bb = smem_all + (n & 1) * 73728;
      u16* sQ = (u16*)bb; u16* sK = sQ + 64 * 136; u16* sKT = sK + 64 * 136; u16* sT = sKT + 128 * 72; u16* sAt = sT + 64 * 72;
      float* sgc = (float*)(bb + 71680); float* sbt = sgc + 64; float* sD = sgc + 128;
      tid = RAWTID & 255;
      wv = tid >> 6; r = tid & 31; h = (tid >> 5) & 1;
      f32x16 VN[2];
      bf16x8 Sb[8];
      {
        f32x16 KS[2];
#pragma unroll
        for (int mt = 0; mt < 2; ++mt)
#pragma unroll
          for (int i = 0; i < 16; ++i) KS[mt][i] = 0.f;
        {
          bf16x8 fa[3][2];
#define LDG_(g_) { fa[(g_) % 3][0] = ldA_perm(sK + r * 136 + ((g_) >> 1) * 32, (g_) & 1, h); fa[(g_) % 3][1] = ldA_perm(sK + (32 + r) * 136 + ((g_) >> 1) * 32, (g_) & 1, h); }
          LDG_(0) LDG_(1)
          __builtin_amdgcn_sched_barrier(0);
#pragma unroll
          for (int g = 0; g < 8; ++g) {
            if (g + 2 < 8) LDG_(g + 2)
            Sb[g] = pack_step(S[g >> 1], g & 1);
            KS[0] = MFMA(fa[g % 3][0], Sb[g], KS[0]);
            KS[1] = MFMA(fa[g % 3][1], Sb[g], KS[1]);
            __builtin_amdgcn_sched_barrier(0);
          }
#undef LDG_
        }
        bf16x8 Rb[2][2];
#pragma unroll
        for (int mt = 0; mt < 2; ++mt) {
          f32x16 R;
#pragma unroll
          for (int g = 0; g < 4; ++g) {
            const float4 b4 = *(const float4*)(sbt + mt * 32 + 8 * g + 4 * h);
            const float4 e4 = *(const float4*)(sgc + mt * 32 + 8 * g + 4 * h);
            R[4 * g + 0] = b4.x * (vv[mt][4 * g + 0] - e4.x * KS[mt][4 * g + 0]);
            R[4 * g + 1] = b4.y * (vv[mt][4 * g + 1] - e4.y * KS[mt][4 * g + 1]);
            R[4 * g + 2] = b4.z * (vv[mt][4 * g + 2] - e4.z * KS[mt][4 * g + 2]);
            R[4 * g + 3] = b4.w * (vv[mt][4 * g + 3] - e4.w * KS[mt][4 * g + 3]);
          }
          Rb[mt][0] = pack_step(R, 0); Rb[mt][1] = pack_step(R, 1);
        }
#pragma unroll
        for (int mo = 0; mo < 2; ++mo)
#pragma unroll
          for (int i = 0; i < 16; ++i) VN[mo][i] = 0.f;
#pragma unroll
        for (int mt = 0; mt < 2; ++mt)
#pragma unroll
          for (int s = 0; s < 2; ++s)
#pragma unroll
            for (int mo = 0; mo < 2; ++mo) {
              bf16x8 at = ldA_perm(sT + (mo * 32 + r) * 72 + mt * 32, s, h);
              VN[mo] = MFMA(at, Rb[mt][s], VN[mo]);
            }
      }
      __builtin_amdgcn_sched_barrier(0);
      if (n + 1 < nchunk) VV_LOAD(n + 1);
      __builtin_amdgcn_sched_barrier(0);
      bf16x8 Vb[2][2];
#pragma unroll
      for (int mt = 0; mt < 2; ++mt) { Vb[mt][0] = pack_step(VN[mt], 0); Vb[mt][1] = pack_step(VN[mt], 1); }
      tid = RAWTID & 255;
      wv = tid >> 6; r = tid & 31; h = (tid >> 5) & 1;
      {
        f32x16 O[2];
#pragma unroll
        for (int mo = 0; mo < 2; ++mo)
#pragma unroll
          for (int i = 0; i < 16; ++i) O[mo][i] = 0.f;
        {
          bf16x8 fa[3][2];
#define LDG_(g_) { fa[(g_) % 3][0] = ldA_perm(sQ + r * 136 + ((g_) >> 1) * 32, (g_) & 1, h); fa[(g_) % 3][1] = ldA_perm(sQ + (32 + r) * 136 + ((g_) >> 1) * 32, (g_) & 1, h); }
          LDG_(0) LDG_(1)
          __builtin_amdgcn_sched_barrier(0);
#pragma unroll
          for (int g = 0; g < 8; ++g) {
            if (g + 2 < 8) LDG_(g + 2)
            O[0] = MFMA(Sb[g], fa[g % 3][0], O[0]);
            O[1] = MFMA(Sb[g], fa[g % 3][1], O[1]);
            __builtin_amdgcn_sched_barrier(0);
          }
#undef LDG_
        }
#pragma unroll
        for (int mo = 0; mo < 2; ++mo) {
          const float e = sgc[mo * 32 + r];
#pragma unroll
          for (int i = 0; i < 16; ++i) O[mo][i] *= e;
        }
#pragma unroll
        for (int mt = 0; mt < 2; ++mt)
#pragma unroll
          for (int s = 0; s < 2; ++s)
#pragma unroll
            for (int mo = 0; mo < 2; ++mo) {
              bf16x8 aa = ldA_perm(sAt + (mo * 32 + r) * 72 + mt * 32, s, h);
              O[mo] = MFMA(Vb[mt][s], aa, O[mo]);
            }
#pragma unroll
        for (int mo = 0; mo < 2; ++mo) {
          const int pos = mo * 32 + r;
          const int tok = t0 + (d ? 63 - pos : pos);
          u16* orow = odst + (size_t)tok * 512 + hd * 128 + wv * 32 + 4 * h;
#pragma unroll
          for (int g = 0; g < 4; ++g) {
            uint2 o2;
            o2.x = pack2(O[mo][4 * g + 0], O[mo][4 * g + 1]);
            o2.y = pack2(O[mo][4 * g + 2], O[mo][4 * g + 3]);
            *(uint2*)(orow + 8 * g) = o2;
          }
        }
        __builtin_amdgcn_sched_barrier(0);
      }
      const float eg = sgc[63];
#pragma unroll
      for (int mt = 0; mt < 2; ++mt) {
#pragma unroll
        for (int g = 0; g < 4; ++g) {
          const float4 d4 = *(const float4*)(sD + mt * 32 + 8 * g + 4 * h);
          VN[mt][4 * g + 0] *= d4.x; VN[mt][4 * g + 1] *= d4.y; VN[mt][4 * g + 2] *= d4.z; VN[mt][4 * g + 3] *= d4.w;
        }
        Vb[mt][0] = pack_step(VN[mt], 0); Vb[mt][1] = pack_step(VN[mt], 1);
      }
#pragma unroll
      for (int kt = 0; kt < 4; ++kt)
#pragma unroll
        for (int i = 0; i < 16; ++i) S[kt][i] *= eg;
      {
        bf16x8 fa[3][2];
#define LDK1_(dst_, kt_, mt_, s_) { const u16* krow_ = sKT + ((kt_) * 32 + r) * 72; const int gsw = 4 * (((kt_) * 4 + (r >> 3)) & 15); \
          s16x4 klo = *(const s16x4*)(krow_ + (((mt_) * 32 + 16 * (s_) + 4 * h) ^ gsw)); s16x4 khi = *(const s16x4*)(krow_ + (((mt_) * 32 + 16 * (s_) + 8 + 4 * h) ^ gsw)); \
          dst_ = __builtin_shufflevector(klo, khi, 0, 1, 2, 3, 4, 5, 6, 7); }
#define LDG_(g_) { LDK1_(fa[(g_) % 3][0], 2 * ((g_) & 1), (g_) >> 2, ((g_) >> 1) & 1) LDK1_(fa[(g_) % 3][1], 2 * ((g_) & 1) + 1, (g_) >> 2, ((g_) >> 1) & 1) }
        LDG_(0) LDG_(1)
        __builtin_amdgcn_sched_barrier(0);
#pragma unroll
        for (int g = 0; g < 8; ++g) {
          if (g + 2 < 8) LDG_(g + 2)
          S[2 * (g & 1)] = MFMA(fa[g % 3][0], Vb[g >> 2][(g >> 1) & 1], S[2 * (g & 1)]);
          S[2 * (g & 1) + 1] = MFMA(fa[g % 3][1], Vb[g >> 2][(g >> 1) & 1], S[2 * (g & 1) + 1]);
          __builtin_amdgcn_sched_barrier(0);
        }
#undef LDG_
#undef LDK1_
      }
      __syncthreads();
    }
    __builtin_amdgcn_s_setprio(0);
  }
#undef PF1
#undef PF_LOAD
#undef VV_LOAD
#undef PS1
#undef XPF1
#undef XPF_LOAD
#undef XPS1
#undef XSTORE
#undef XWARM
}

DI void phase_onorm(const Params& p, const int wid_s, int l) {
  const u16* of = (const u16*)(p.ws + OFF_R3);
  const u16* ob = (const u16*)(p.ws + OFF_OB);
  u16* z = (u16*)(p.ws + OFF_R2);
  int tid_ = VTID; asm volatile("" : "+v"(tid_)); const int tid = tid_, lane = tid & 63, wv = tid >> 6;
  float gn[8];
#pragma unroll
  for (int e = 0; e < 8; ++e) gn[e] = p.dn_norm[l * 128 + ((lane * 8 + e) & 127)];
  for (int it = VB; it < 1536; it += VGRID) {
    uint4 la[4], lb[4], lz[4];
#pragma unroll
    for (int rr = 0; rr < 4; ++rr) {
      const size_t off = (size_t)(it * 16 + wv * 4 + rr) * 512 + lane * 8;
      la[rr] = nt_load4u(of + off); lb[rr] = nt_load4u(ob + off); lz[rr] = nt_load4u(z + off);
    }
#pragma unroll
    for (int rr = 0; rr < 4; ++rr) {
      const int t = it * 16 + wv * 4 + rr;
      const size_t off = (size_t)t * 512 + lane * 8;
      const uint4 a = la[rr], b = lb[rr], zz = lz[rr];
      float o[8];
      o[0] = bflo(a.x) + bflo(b.x); o[1] = bfhi(a.x) + bfhi(b.x); o[2] = bflo(a.y) + bflo(b.y); o[3] = bfhi(a.y) + bfhi(b.y);
      o[4] = bflo(a.z) + bflo(b.z); o[5] = bfhi(a.z) + bfhi(b.z); o[6] = bflo(a.w) + bflo(b.w); o[7] = bfhi(a.w) + bfhi(b.w);
      float zf[8] = {bflo(zz.x), bfhi(zz.x), bflo(zz.y), bfhi(zz.y), bflo(zz.z), bfhi(zz.z), bflo(zz.w), bfhi(zz.w)};
      float ss = 0.f;
#pragma unroll
      for (int e = 0; e < 8; ++e) ss += o[e] * o[e];
      ss += __shfl_xor(ss, 1); ss += __shfl_xor(ss, 2); ss += __shfl_xor(ss, 4); ss += __shfl_xor(ss, 8);
      const float rstd = rsqrtf(ss * (1.f / 128.f) + EPSF);
      float y[8];
#pragma unroll
      for (int e = 0; e < 8; ++e) y[e] = o[e] * rstd * gn[e] * siluf(zf[e]);
      uint4 w;
      w.x = pack2(y[0], y[1]); w.y = pack2(y[2], y[3]); w.z = pack2(y[4], y[5]); w.w = pack2(y[6], y[7]);
      *(uint4*)(z + off) = w;
    }
  }
}

DI void phase_final(const Params& p, const int wid_s) {
  const float* adap = (const float*)(p.ws + OFF_ADAP);
  const u16* delta = (const u16*)(p.ws + OFF_R2);
  int tid_ = VTID; asm volatile("" : "+v"(tid_)); const int tid = tid_, lane = tid & 63, wv = tid >> 6;
  float g[16];
#pragma unroll
  for (int q = 0; q < 4; ++q)
#pragma unroll
    for (int e = 0; e < 4; ++e) g[q * 4 + e] = p.final_norm[q * 256 + lane * 4 + e];
  for (int it = VB; it < 1536; it += VGRID) {
    const int ci = cond_idx(it * 16);
    float gt[16];
#pragma unroll
    for (int q = 0; q < 4; ++q)
#pragma unroll
      for (int e = 0; e < 4; ++e) gt[q * 4 + e] = ada_get(adap, 1, ci, 5 * 1024 + q * 256 + lane * 4 + e);
    float4 v[4][4];
    uint2 dl[4][4];
#pragma unroll
    for (int rr = 0; rr < 4; ++rr) {
      const int t = it * 16 + wv * 4 + rr;
#pragma unroll
      for (int q = 0; q < 4; ++q) {
        v[rr][q] = nt_load4f(p.out + (size_t)t * DM + q * 256 + lane * 4);
        dl[rr][q] = nt_load2u(delta + (size_t)t * 1024 + q * 256 + lane * 4);
      }
    }
#pragma unroll
    for (int rr = 0; rr < 4; ++rr) {
      const int t = it * 16 + wv * 4 + rr;
      float* xr = p.out + (size_t)t * DM;
      float ss = 0.f;
#pragma unroll
      for (int q = 0; q < 4; ++q) {
        const uint2 d2 = dl[rr][q];
        v[rr][q].x += gt[q * 4 + 0] * bflo(d2.x); v[rr][q].y += gt[q * 4 + 1] * bfhi(d2.x);
        v[rr][q].z += gt[q * 4 + 2] * bflo(d2.y); v[rr][q].w += gt[q * 4 + 3] * bfhi(d2.y);
        ss += v[rr][q].x * v[rr][q].x + v[rr][q].y * v[rr][q].y + v[rr][q].z * v[rr][q].z + v[rr][q].w * v[rr][q].w;
      }
#pragma unroll
      for (int o = 32; o > 0; o >>= 1) ss += __shfl_xor(ss, o);
      const float rstd = rsqrtf(ss * (1.f / 1024.f) + EPSF);
#pragma unroll
      for (int q = 0; q < 4; ++q) {
        float4 o4;
        o4.x = v[rr][q].x * rstd * g[q * 4 + 0]; o4.y = v[rr][q].y * rstd * g[q * 4 + 1];
        o4.z = v[rr][q].z * rstd * g[q * 4 + 2]; o4.w = v[rr][q].w * rstd * g[q * 4 + 3];
        nt_store4f(xr + q * 256 + lane * 4, o4);
      }
    }
  }
}

constexpr size_t OFF_BAR = 255524864;
constexpr int BAR_WORDS = 64 * 34;
DI unsigned xb_ld(unsigned* q) { return __hip_atomic_load(q, __ATOMIC_RELAXED, __HIP_MEMORY_SCOPE_AGENT); }
DI unsigned xb_add(unsigned* q, unsigned v) { return __hip_atomic_fetch_add(q, v, __ATOMIC_RELAXED, __HIP_MEMORY_SCOPE_AGENT); }
DI void xb_st(unsigned* q, unsigned v) { __hip_atomic_store(q, v, __ATOMIC_RELAXED, __HIP_MEMORY_SCOPE_AGENT); }
DI void fast_barrier(unsigned* bar, unsigned& bk, const int wid_s) {
  asm volatile("s_waitcnt vmcnt(0)" ::: "memory");
  __syncthreads();
  ++bk;
  if (RAWTID == 0) {
    const unsigned G = gridDim.x; unsigned g = blockIdx.x & 15u;
    asm volatile("" : "+s"(g));
    const unsigned gsize = (G - g + 15u) >> 4;
    const unsigned ngroups = G < 16u ? G : 16u;
    __builtin_amdgcn_fence(__ATOMIC_RELEASE, "agent");
    asm volatile("s_waitcnt vmcnt(0)" ::: "memory");
    const unsigned old = xb_add(&bar[64 * g], 1u);
    if (old + 1u == bk * gsize) {
      const unsigned o2 = xb_add(&bar[64 * 32], 1u);
      if (o2 + 1u == bk * ngroups) xb_st(&bar[64 * 33], bk);
      else while (xb_ld(&bar[64 * 33]) < bk) __builtin_amdgcn_s_sleep(1);
      xb_st(&bar[64 * (16 + g)], bk);
    } else {
      while (xb_ld(&bar[64 * (16 + g)]) < bk) __builtin_amdgcn_s_sleep(1);
    }
    __builtin_amdgcn_fence(__ATOMIC_ACQUIRE, "agent");
    asm volatile("s_waitcnt vmcnt(0)" ::: "memory");
  }
  __syncthreads();
}
#define GSYNC() fast_barrier(bar, bk, wid_s)
__global__ void __launch_bounds__(512, 2) fwd_megakernel(Params p) {
  __shared__ __attribute__((aligned(16))) char smem_all[147456];
  cg::grid_group grid = cg::this_grid();
  unsigned* bar = (unsigned*)(p.ws + OFF_BAR);
  unsigned bk = 0;
  const int wid_s = __builtin_amdgcn_readfirstlane(threadIdx.x >> 6);
  if (p.out == nullptr) grid.sync();
#define smem (smem_all + (wid_s >> 2) * 73728)
  phase_ada(p, wid_s, smem);
  phase_wconv(p, wid_s, 0, smem, 0, 704, false, VB, VGRID);
  GSYNC();
#pragma unroll 1
  for (int l = 0; l < 2; ++l) {
    phase_modnorm(p, wid_s, l, 0, l == 0, (u16*)(p.ws + OFF_R1), l == 0 ? nullptr : (const u16*)(p.ws + OFF_R2), l - 1, 5);
    GSYNC();
    gemm8p<EPI_PROJ>(p, wid_s, l, (const u16*)(p.ws + OFF_R1), (const u16*)(p.ws + OFF_R1), 1024, 1024,
                    (const u16*)(p.ws + OFF_WIN), 1024, 1024, 10, 0, false, smem_all);
    ab_sliver(p, wid_s, smem_all);
    GSYNC();
    phase_conv_pool(p, wid_s, l, smem);
    GSYNC();
    phase_intra(p, wid_s, l, smem);
    GSYNC();
    if (blockIdx.x < 64) {
      phase_scan_lat8(p, wid_s, l, smem_all);
    } else {
      phase_scan(p, wid_s, l, smem);
      const int hb = VB - 128, nhb = VGRID - 128;
      phase_wconv(p, wid_s, l, smem, 704, 3072, true, hb, nhb);
      if (l == 0) phase_wconv(p, wid_s, 1, smem, 0, 704, false, hb, nhb);
    }
    GSYNC();
    phase_onorm(p, wid_s, l);
    GSYNC();
    gemm8p<EPI_RESID>(p, wid_s, l, (const u16*)(p.ws + OFF_R2), (const u16*)(p.ws + OFF_R4), 512, 512,
                      (const u16*)(p.ws + OFF_WOUT), 1024, 1024, 4, 2, false, smem_all);
    GSYNC();
    phase_modnorm(p, wid_s, l, 1, l == 0, (u16*)(p.ws + OFF_R2), (const u16*)(p.ws + OFF_R1), l, 2);
    GSYNC();
    gemm8p<EPI_SWIGLU>(p, wid_s, l, (const u16*)(p.ws + OFF_R2), (const u16*)(p.ws + OFF_R2), 1024, 1024,
                      (const u16*)(p.ws + OFF_WGU), 1024, 1024, 22, 0, false, smem_all);
    GSYNC();
    gemm8p<EPI_RESID>(p, wid_s, l, (const u16*)(p.ws + OFF_R0), (const u16*)(p.ws + OFF_R0), DFF, DFF,
                      (const u16*)(p.ws + OFF_WDN), DFF, DFF, 4, 5, false, smem_all);
    GSYNC();
  }
  phase_final(p, wid_s);
}

extern "C" void kernel_launch(void* const* d_in, const int* in_sizes, int n_in, void* d_out, int out_size, void* d_ws,
                              size_t ws_size, hipStream_t stream) {
  static int grid_blocks = 0;
  if (!grid_blocks) {
    int dev = 0, cus = 0, per_cu = 0;
    (void)hipGetDevice(&dev);
    (void)hipDeviceGetAttribute(&cus, hipDeviceAttributeMultiprocessorCount, dev);
    (void)hipOccupancyMaxActiveBlocksPerMultiprocessor(&per_cu, fwd_megakernel, 512, 0);
    if (per_cu > 1) per_cu = 1;
    if (per_cu < 1) per_cu = 1;
    grid_blocks = cus * per_cu;
  }
  Params p{};
  const float** pf = (const float**)&p;
  for (int i = 0; i < 20; ++i) pf[i] = (const float*)d_in[i];
  p.out = (float*)d_out;
  p.ws = (char*)d_ws;
  (void)hipMemsetAsync((char*)d_ws + OFF_BAR, 0, BAR_WORDS * sizeof(unsigned) + (size_t)2 * 9 * 6144 * sizeof(float), stream);
  void* args[] = {&p};
  hipError_t e = hipLaunchCooperativeKernel((void*)fwd_megakernel, dim3(grid_blocks), dim3(512), args, 0, stream);
  if (e != hipSuccess) fprintf(stderr, "cooperative launch failed: %s (grid %d)\n", hipGetErrorString(e), grid_blocks);
}
```
